# Optimizing an MI355X kernel written in HIP

```python
import math
import jax, jax.numpy as jnp
from jax import lax
import numpy as np

D_MODEL = 2048
BATCH = 4
SEQ = 4096
DEPTH = 2

GRID_W = 64
CTX_LEN = 256

N_HEADS = D_MODEL // 128
QK_NOPE = 128
QK_ROPE = 64
V_DIM = 128
Q_RANK = 384
KV_RANK = 512
ROPE_THETA = 10000.0
Q_BLOCK = 128

POOL_DIM = 1024
POOL_GROUPS = 4
POOL_GROUP_DIM = POOL_DIM // POOL_GROUPS
POOL_WINDOWS = (2, 4, 8, 16)
POOL_GROUP_OUT = D_MODEL // POOL_GROUPS

KV_COLS = KV_RANK + QK_ROPE
Q_END = KV_COLS + Q_RANK
POOL_END = Q_END + POOL_DIM
IN_COLS = POOL_END + 2 * D_MODEL

N_EXPERTS = 16
N_GROUPS = 4
EXPERTS_PER_GROUP = N_EXPERTS // N_GROUPS
TOP_K = 2
D_EXPERT = 512
D_SHARED = 512

EPS = 1e-6
N_MOD = 6

kernel_name = "hybrid_mla_pool_moe_dit_block"


def _rmsnorm(x, g):
    xf = x.astype(jnp.float32)
    y = xf * lax.rsqrt(jnp.mean(xf * xf, axis=-1, keepdims=True) + EPS)
    return y.astype(x.dtype) * g


def _modulate(h, shift, scale):
    return h * (1 + scale) + shift


def _axial_rope_tables(rows):
    row = jnp.repeat(jnp.arange(rows), GRID_W).astype(jnp.float32)
    col = jnp.tile(jnp.arange(GRID_W), rows).astype(jnp.float32)
    axis_dim = QK_ROPE // 2
    inv = ROPE_THETA ** (-jnp.arange(0, axis_dim, 2, dtype=jnp.float32) / axis_dim)
    ang = jnp.concatenate([row[:, None] * inv, col[:, None] * inv], axis=-1)
    return jnp.cos(ang), jnp.sin(ang)


def _apply_rope(x, cos, sin):
    half = x.shape[-1] // 2
    x1, x2 = x[..., :half], x[..., half:]
    cos = cos.astype(x.dtype)
    sin = sin.astype(x.dtype)
    return jnp.concatenate([x1 * cos - x2 * sin, x2 * cos + x1 * sin], axis=-1)


def _mla_keys(p_kv, kv_norm_g, w_kvb, cos, sin):
    b, n, _ = p_kv.shape
    kv = (_rmsnorm(p_kv[..., :KV_RANK], kv_norm_g) @ w_kvb).reshape(b, n, N_HEADS, QK_NOPE + V_DIM)
    k_nope, v = kv[..., :QK_NOPE], kv[..., QK_NOPE:]
    k_pe = p_kv[..., KV_RANK:]
    if cos is not None:
        k_pe = _apply_rope(k_pe, cos, sin)
    k_pe = jnp.broadcast_to(k_pe[:, :, None, :], (b, n, N_HEADS, QK_ROPE))
    return jnp.concatenate([k_nope, k_pe], axis=-1), v


def _mla_queries(q_lat, q_norm_g, w_qb, cos, sin):
    b, n, _ = q_lat.shape
    q = (_rmsnorm(q_lat, q_norm_g) @ w_qb).reshape(b, n, N_HEADS, QK_NOPE + QK_ROPE)
    q_nope, q_pe = q[..., :QK_NOPE], q[..., QK_NOPE:]
    if cos is not None:
        q_pe = _apply_rope(q_pe, cos[:, None, :], sin[:, None, :])
    return jnp.concatenate([q_nope, q_pe], axis=-1)


def _attend(q, k, v):
    b, n, h, dq = q.shape
    nb = n // Q_BLOCK
    scale = 1.0 / math.sqrt(dq)
    qb = q.reshape(b, nb, Q_BLOCK, h, dq).transpose(1, 0, 2, 3, 4)

    def block(q_blk):
        s = jnp.einsum('bqhd,bkhd->bhqk', q_blk, k, preferred_element_type=jnp.float32) * scale
        p = jax.nn.softmax(s, axis=-1).astype(v.dtype)
        return jnp.einsum('bhqk,bkhd->bqhd', p, v)

    o = lax.map(block, qb)
    return o.transpose(1, 0, 2, 3, 4).reshape(b, n, h * v.shape[-1])


def _multiscale_pool(u, w_pool, pool_scale):
    b, n, _ = u.shape
    uf = u.astype(jnp.float32)
    cs = jnp.concatenate([jnp.zeros((b, 1, POOL_DIM), jnp.float32), jnp.cumsum(uf, axis=1)], axis=1)
    t = jnp.arange(n)
    outs = []
    for g, w in enumerate(POOL_WINDOWS):
        lo = jnp.clip(t - w // 2, 0, n)
        hi = jnp.clip(t + w // 2, 0, n)
        sl = slice(g * POOL_GROUP_DIM, (g + 1) * POOL_GROUP_DIM)
        csg = cs[..., sl]
        mean = (csg[:, hi] - csg[:, lo]) / (hi - lo).astype(jnp.float32)[:, None]
        outs.append(mean - uf[..., sl])
    z = jnp.stack(outs, axis=2).astype(u.dtype)
    y = jnp.einsum('bngc,gcd->bngd', z, w_pool).reshape(b, n, D_MODEL)
    return y * pool_scale


def _mixer_out(p, k_all, v_all, cos, sin, q_norm_g, w_qb, w_pool, pool_scale, w_out):
    q = _mla_queries(p[..., KV_COLS:Q_END], q_norm_g, w_qb, cos, sin)
    y_mla = _attend(q, k_all, v_all)
    y_pool = _multiscale_pool(p[..., Q_END:POOL_END], w_pool, pool_scale)
    g_mla = jax.nn.sigmoid(p[..., POOL_END:POOL_END + D_MODEL])
    g_pool = jax.nn.sigmoid(p[..., POOL_END + D_MODEL:])
    return (g_mla * y_mla + g_pool * y_pool) @ w_out


def _swiglu(t, wg, wu, wd):
    return (jax.nn.silu(t @ wg) * (t @ wu)) @ wd


def _moe(h, w_router, router_bias, wg, wu, wd, sg, su, sd):
    shape = h.shape
    t = h.reshape(-1, D_MODEL)
    scores = jax.nn.sigmoid((t @ w_router).astype(jnp.float32))
    sel = scores + router_bias.astype(jnp.float32)
    grp = sel.reshape(-1, N_GROUPS, EXPERTS_PER_GROUP)
    grp_score = lax.top_k(grp, TOP_K)[0].sum(axis=-1)
    g_idx = jnp.argmax(grp_score, axis=-1)
    in_grp = jnp.take_along_axis(grp, g_idx[:, None, None], axis=1)[:, 0]
    _, local = lax.top_k(in_grp, TOP_K)
    expert = g_idx[:, None] * EXPERTS_PER_GROUP + local
    w = jnp.take_along_axis(scores, expert, axis=-1)
    w = w / jnp.sum(w, axis=-1, keepdims=True)
    combine = jnp.einsum('tk,tke->te', w, jax.nn.one_hot(expert, N_EXPERTS, dtype=jnp.float32)).astype(t.dtype)
    y = _swiglu(t, sg, su, sd)
    for e in range(N_EXPERTS):
        y = y + combine[:, e:e + 1] * _swiglu(t, wg[e], wu[e], wd[e])
    return y.reshape(shape)


def setup_inputs(seed: int = 0) -> dict:
    key = jax.random.key(seed)
    ks = jax.random.split(key, 32)
    L, D = DEPTH, D_MODEL

    def nrm(k, shape, scale):
        return jax.random.normal(k, shape, jnp.float32) * scale

    def gain(k, shape):
        return 1.0 + nrm(k, shape, 0.02)

    return {
        'x': nrm(ks[0], (BATCH, SEQ, D), 1.0),
        'c': nrm(ks[1], (BATCH, D), 1.0),
        'ctx': nrm(ks[2], (BATCH, CTX_LEN, D), 1.0),
        'c_ctx': nrm(ks[3], (D,), 1.0),
        'w_ada': nrm(ks[4], (L, D, N_MOD * D), 0.5 * D ** -0.5),
        'b_ada': nrm(ks[5], (L, N_MOD * D), 0.02),
        'norm_mix_g': gain(ks[6], (L, D)),
        'norm_ffn_g': gain(ks[7], (L, D)),
        'w_in': nrm(ks[8], (L, D, IN_COLS), D ** -0.5),
        'q_norm_g': gain(ks[9], (L, Q_RANK)),
        'kv_norm_g': gain(ks[10], (L, KV_RANK)),
        'w_qb': nrm(ks[11], (L, Q_RANK, N_HEADS * (QK_NOPE + QK_ROPE)), Q_RANK ** -0.5),
        'w_kvb': nrm(ks[12], (L, KV_RANK, N_HEADS * (QK_NOPE + V_DIM)), KV_RANK ** -0.5),
        'w_pool': nrm(ks[13], (L, POOL_GROUPS, POOL_GROUP_DIM, POOL_GROUP_OUT), POOL_GROUP_DIM ** -0.5),
        'pool_scale': 1.0 + nrm(ks[14], (L, D), 0.1),
        'w_out': nrm(ks[15], (L, D, D), D ** -0.5),
        'w_router': nrm(ks[16], (D, N_EXPERTS), D ** -0.5),
        'router_bias': nrm(ks[17], (N_EXPERTS,), 0.01),
        'w_exp_gate': nrm(ks[18], (L, N_EXPERTS, D, D_EXPERT), D ** -0.5),
        'w_exp_up': nrm(ks[19], (L, N_EXPERTS, D, D_EXPERT), D ** -0.5),
        'w_exp_down': nrm(ks[20], (L, N_EXPERTS, D_EXPERT, D), D_EXPERT ** -0.5),
        'w_sh_gate': nrm(ks[21], (L, D, D_SHARED), D ** -0.5),
        'w_sh_up': nrm(ks[22], (L, D, D_SHARED), D ** -0.5),
        'w_sh_down': nrm(ks[23], (L, D_SHARED, D), D_SHARED ** -0.5),
        'final_norm_g': gain(ks[24], (D,)),
    }


def reference(x, c, ctx, c_ctx, w_ada, b_ada, norm_mix_g, norm_ffn_g, w_in, q_norm_g, kv_norm_g,
              w_qb, w_kvb, w_pool, pool_scale, w_out, w_router, router_bias,
              w_exp_gate, w_exp_up, w_exp_down, w_sh_gate, w_sh_up, w_sh_down, final_norm_g):
    seq = x.shape[1]
    rows = seq // GRID_W
    cos, sin = _axial_rope_tables(rows)
    xc = ctx
    for l in range(DEPTH):
        last = l == DEPTH - 1
        mod = jax.nn.silu(c) @ w_ada[l] + b_ada[l]
        mod_c = jax.nn.silu(c_ctx) @ w_ada[l] + b_ada[l]
        sh1, sc1, g1, sh2, sc2, g2 = [m[:, None, :] for m in jnp.split(mod, N_MOD, axis=-1)]
        sh1c, sc1c, g1c, sh2c, sc2c, g2c = jnp.split(mod_c, N_MOD, axis=-1)

        h = _modulate(_rmsnorm(x, norm_mix_g[l]), sh1, sc1)
        hc = _modulate(_rmsnorm(xc, norm_mix_g[l]), sh1c, sc1c)
        p = h @ w_in[l]
        pc = hc @ (w_in[l][:, :KV_COLS] if last else w_in[l])
        k_lat, v_lat = _mla_keys(p[..., :KV_COLS], kv_norm_g[l], w_kvb[l], cos, sin)
        k_ctx, v_ctx = _mla_keys(pc[..., :KV_COLS], kv_norm_g[l], w_kvb[l], None, None)
        k_all = jnp.concatenate([k_ctx, k_lat], axis=1)
        v_all = jnp.concatenate([v_ctx, v_lat], axis=1)
        y = _mixer_out(p, k_all, v_all, cos, sin, q_norm_g[l], w_qb[l], w_pool[l], pool_scale[l], w_out[l])
        x = x + g1 * y
        if not last:
            yc = _mixer_out(pc, k_ctx, v_ctx, None, None, q_norm_g[l], w_qb[l], w_pool[l], pool_scale[l], w_out[l])
            xc = xc + g1c * yc

        h2 = _modulate(_rmsnorm(x, norm_ffn_g[l]), sh2, sc2)
        moe_args = (w_router, router_bias, w_exp_gate[l], w_exp_up[l], w_exp_down[l],
                    w_sh_gate[l], w_sh_up[l], w_sh_down[l])
        if last:
            x = x + g2 * _moe(h2, *moe_args)
        else:
            h2c = _modulate(_rmsnorm(xc, norm_ffn_g[l]), sh2c, sc2c)
            n_ctx = xc.shape[1]
            f = _moe(jnp.concatenate([h2c, h2], axis=1), *moe_args)
            xc = xc + g2c * f[:, :n_ctx]
            x = x + g2 * f[:, n_ctx:]
    return _rmsnorm(x, final_norm_g)
```

```cpp
#include <hip/hip_runtime.h>
#include <cstdio>
#include <cstdint>

#ifndef MK_PER_PHASE
#define MK_PER_PHASE 1
#endif

#define LAS __attribute__((address_space(3)))
#define GAS __attribute__((address_space(1)))
typedef unsigned short bf16;
typedef short bf16x8 __attribute__((ext_vector_type(8)));
typedef short s16x4 __attribute__((ext_vector_type(4)));
typedef float f32x2 __attribute__((ext_vector_type(2)));
typedef float f32x4 __attribute__((ext_vector_type(4)));
typedef float f32x16 __attribute__((ext_vector_type(16)));
typedef unsigned u32x2 __attribute__((ext_vector_type(2)));
typedef unsigned u32x4 __attribute__((ext_vector_type(4)));

constexpr int DM = 2048, NBATCH = 4, SEQ = 4096, CTX = 256, RPB = SEQ + CTX, T = NBATCH * RPB, NH = 16, DEPTH = 2;
constexpr int IN_COLS = 6080, NP = 6144, NKV = 4096, NQ = 3072, NZ = 1024, NACT = 1536;
constexpr int P_Q = 512, P_KPE = 896, P_POOL = 1024, P_GM = 2048, P_GP = 4096;
constexpr int NPAIR = 24, NMOD = 6 * DM;
constexpr float EPS = 1e-6f;
constexpr int NWAVES = 8;

constexpr size_t MiB = 1u << 20;
constexpr size_t WS_CTL = 0, CTL_ZERO_BYTES = 1 * MiB;
constexpr size_t WS_LTOK = 4 * MiB, WS_LWA = 6 * MiB, WS_LWB = 8 * MiB;
constexpr size_t WS_MOD = 10 * MiB;
constexpr size_t WS_COS = 11 * MiB, WS_SIN = 12 * MiB;
constexpr size_t WS_W = 16 * MiB;
constexpr size_t LW_IN = 0, LW_KVB = LW_IN + (size_t)NP * DM * 2, LW_QB = LW_KVB + (size_t)NKV * 512 * 2, LW_POOL = LW_QB + (size_t)NQ * 384 * 2,
                 LW_OUT = LW_POOL + (size_t)4 * 512 * 256 * 2, LW_GU = LW_OUT + (size_t)DM * DM * 2, LW_D = LW_GU + (size_t)17 * 1024 * DM * 2,
                 LW_BYTES = LW_D + (size_t)17 * DM * 512 * 2;
constexpr size_t WS_XCTX = 300 * MiB;
constexpr size_t WS_P = 308 * MiB;
constexpr size_t WS_Z = 512 * MiB;
constexpr size_t WS_KPE = 546 * MiB;
constexpr size_t WS_KV = 549 * MiB;
constexpr size_t WS_Q = 685 * MiB;
constexpr size_t WS_HM = 787 * MiB;
constexpr size_t WS_END = 855 * MiB;
static_assert(WS_W + 2 * LW_BYTES <= WS_XCTX, "weights fit");
static_assert(WS_P + (size_t)T * NP * 2 <= WS_Z && WS_KV + (size_t)T * NKV * 2 <= WS_Q && WS_Q + (size_t)T * NQ * 2 <= WS_HM && WS_HM + (size_t)T * DM * 2 <= WS_END, "ws map");
constexpr int CW_BAR = 4096;
constexpr int CW_CNT = 16384;

constexpr int RING_BYTES = 131072;
constexpr int L_CIDX = RING_BYTES, L_CWA = L_CIDX + 8192, L_CWB = L_CWA + 8192, L_TAB = L_CWB + 8192, L_MISC = L_TAB + 512;
constexpr int LDS_BYTES = L_MISC + 512;
constexpr int MAXU = 8;

__device__ __forceinline__ unsigned cvt_pk(float lo, float hi) { unsigned r; asm("v_cvt_pk_bf16_f32 %0, %1, %2" : "=v"(r) : "v"(lo), "v"(hi)); return r; }
__device__ __forceinline__ float bf2f(unsigned h) { return __builtin_bit_cast(float, h << 16); }
__device__ __forceinline__ float bflo(unsigned w) { return __builtin_bit_cast(float, w << 16); }
__device__ __forceinline__ float bfhi(unsigned w) { return __builtin_bit_cast(float, w & 0xffff0000u); }
template <int CTRL> __device__ __forceinline__ float dppf(float v) { return __builtin_bit_cast(float, __builtin_amdgcn_update_dpp(0, __builtin_bit_cast(int, v), CTRL, 0xf, 0xf, true)); }
__device__ __forceinline__ float wave_sum(float v) {
    v += dppf<0xB1>(v);
    v += dppf<0x4E>(v);
    v += dppf<0x141>(v);
    v += dppf<0x140>(v);
    { auto rr = __builtin_amdgcn_permlane16_swap(__float_as_uint(v), __float_as_uint(v), false, false); v = __uint_as_float(rr[0]) + __uint_as_float(rr[1]); }
    { auto rr = __builtin_amdgcn_permlane32_swap(__float_as_uint(v), __float_as_uint(v), false, false); v = __uint_as_float(rr[0]) + __uint_as_float(rr[1]); }
    return v;
}
__device__ __forceinline__ float sigmoidf_(float x) { return __builtin_amdgcn_rcpf(1.f + __builtin_amdgcn_exp2f(-1.4426950408889634f * x)); }
#define LDS_WAIT() asm volatile("s_waitcnt lgkmcnt(0)" ::: "memory")
#define VM_WAIT() asm volatile("s_waitcnt vmcnt(0)" ::: "memory")

#define XB_TMO      128
#define XB_XCNT(j)  (256  + 64 * (j))
#define XB_XSUB(j)  (1280 + 64 * (j))
#define XB_XGEN(j)  (2304 + 64 * (j))
#define XB_TOP      3328
#define XB_TOPGEN   3392
#define XCD_BAR_WORDS 3456
#define XB_SPIN_CAP (1u << 18)
__device__ __forceinline__ unsigned xb_ld(unsigned* p)              { return __hip_atomic_load(p, __ATOMIC_RELAXED, __HIP_MEMORY_SCOPE_AGENT); }
__device__ __forceinline__ unsigned xb_add(unsigned* p, unsigned v) { return __hip_atomic_fetch_add(p, v, __ATOMIC_RELAXED, __HIP_MEMORY_SCOPE_AGENT); }
__device__ __forceinline__ unsigned xb_xcc_id() { return (unsigned)__builtin_amdgcn_s_getreg((3 << 11) | 20) & 0xFu; }
#define XB_SPIN(cond, bar) do { unsigned _sp = 0; while (cond) { __builtin_amdgcn_s_sleep(1); \
    if ((++_sp & 255u) == 0u) { if (xb_ld(&(bar)[XB_TMO])) break; if (_sp > XB_SPIN_CAP) { atomicAdd(&(bar)[XB_TMO], 1u); break; } } } } while (0)
struct XcdBarrier { unsigned* bar; unsigned x; volatile LAS unsigned* st; };
__device__ __forceinline__ XcdBarrier xcd_barrier_post(unsigned* bar, volatile LAS unsigned* st) {
    XcdBarrier b; b.bar = bar; b.x = xb_xcc_id(); b.st = st;
    if (threadIdx.x == 0) (void)xb_add(&bar[XB_XCNT(b.x)], 1u);
    return b;
}
__device__ __forceinline__ void xcd_barrier_complete(unsigned* bar, unsigned x, unsigned& nloc, unsigned& nx) {
    const unsigned G = gridDim.x * gridDim.y * gridDim.z;
    unsigned sum, cnt, mine, sp = 0u;
    for (;;) {
        sum = 0u; cnt = 0u; mine = 0u;
#pragma unroll
        for (unsigned j = 0; j < 16; ++j) { const unsigned c = xb_ld(&bar[XB_XCNT(j)]); sum += c; cnt += (c > 0u) ? 1u : 0u; mine = (j == x) ? c : mine; }
        if (sum == G) break;
        __builtin_amdgcn_s_sleep(1);
        if ((++sp & 255u) == 0u) { if (xb_ld(&bar[XB_TMO])) break; if (sp > XB_SPIN_CAP) { atomicAdd(&bar[XB_TMO], 1u); break; } }
    }
    nloc = mine > 0u ? mine : 1u; nx = cnt > 0u ? cnt : 1u;
}
__device__ __forceinline__ void xcd_barrier(const XcdBarrier& b) {
    asm volatile("s_waitcnt vmcnt(0)" ::: "memory");
    __syncthreads();
    if (threadIdx.x == 0) {
        unsigned* bar = b.bar; const unsigned bx = b.x;
        __builtin_amdgcn_s_waitcnt(0);
        unsigned nloc = b.st[0], nx = b.st[1];
        if (nloc == 0u) { xcd_barrier_complete(bar, bx, nloc, nx); b.st[0] = nloc; b.st[1] = nx; }
        const unsigned old = xb_add(&bar[XB_XSUB(bx)], 1u);
        const unsigned gen = old / nloc;
        if (old + 1u == (gen + 1u) * nloc) {
            __builtin_amdgcn_fence(__ATOMIC_RELEASE, "agent");
            asm volatile("s_waitcnt vmcnt(0)" ::: "memory");
            const unsigned og = xb_add(&bar[XB_TOP], 1u);
            const unsigned tg = og / nx;
            if (og + 1u == (tg + 1u) * nx) xb_add(&bar[XB_TOPGEN], 1u);
            else XB_SPIN(xb_ld(&bar[XB_TOPGEN]) == tg, bar);
            __builtin_amdgcn_fence(__ATOMIC_ACQUIRE, "agent");
            xb_add(&bar[XB_XGEN(bx)], 1u);
            asm volatile("s_waitcnt vmcnt(0)" ::: "memory");
        } else {
            XB_SPIN(xb_ld(&bar[XB_XGEN(bx)]) == gen, bar);
            __builtin_amdgcn_fence(__ATOMIC_ACQUIRE, "agent");
            asm volatile("s_waitcnt vmcnt(0)" ::: "memory");
        }
    }
    __syncthreads();
}

struct Args { const float* in[25]; float* out; unsigned char* ws; int ph_lo, ph_hi; };
struct Frame {
    LAS unsigned char* lds;
    LAS unsigned char* ldsx;
    int tid, lane, wave, vcu, G, bx;
    const __attribute__((address_space(4))) Args* ap;
    __device__ __forceinline__ void fresh() { ap = (const __attribute__((address_space(4))) Args*)__builtin_amdgcn_kernarg_segment_ptr(); asm volatile("" : "+s"(ap));
        int t = threadIdx.x; asm volatile("" : "+v"(t)); tid = t; lane = t & 63; wave = __builtin_amdgcn_readfirstlane(t >> 6);
        unsigned z = 0; asm volatile("" : "+s"(z)); ldsx = lds + z;
        int g = gridDim.x, b = blockIdx.x; asm volatile("" : "+s"(g), "+s"(b)); G = g; bx = b; vcu = (g % 8 == 0) ? (b % 8) * (g / 8) + b / 8 : b; }
    __device__ __forceinline__ const float* in(int i) const { return ap->in[i]; }
    __device__ __forceinline__ float* out() const { return ap->out; }
    __device__ __forceinline__ unsigned char* ws() const { return ap->ws; }
    __device__ __forceinline__ unsigned* ctl() const { return (unsigned*)(ap->ws + WS_CTL); }
    __device__ __forceinline__ float* xctx() const { return (float*)(ap->ws + WS_XCTX); }
    __device__ __forceinline__ bf16* P() const { return (bf16*)(ap->ws + WS_P); }
    __device__ __forceinline__ bf16* ACT() const { return (bf16*)(ap->ws + WS_P); }
    __device__ __forceinline__ bf16* Z() const { return (bf16*)(ap->ws + WS_Z); }
    __device__ __forceinline__ bf16* KPE() const { return (bf16*)(ap->ws + WS_KPE); }
    __device__ __forceinline__ bf16* KV() const { return (bf16*)(ap->ws + WS_KV); }
    __device__ __forceinline__ bf16* Q() const { return (bf16*)(ap->ws + WS_Q); }
    __device__ __forceinline__ bf16* HM() const { return (bf16*)(ap->ws + WS_HM); }
    __device__ __forceinline__ float* mod() const { return (float*)(ap->ws + WS_MOD); }
    __device__ __forceinline__ float* cosT() const { return (float*)(ap->ws + WS_COS); }
    __device__ __forceinline__ float* sinT() const { return (float*)(ap->ws + WS_SIN); }
    __device__ __forceinline__ int* ltok() const { return (int*)(ap->ws + WS_LTOK); }
    __device__ __forceinline__ float* lwa() const { return (float*)(ap->ws + WS_LWA); }
    __device__ __forceinline__ float* lwb() const { return (float*)(ap->ws + WS_LWB); }
};
__device__ __forceinline__ const float* xin_row(const Frame& F, int r) { const int b = r / RPB, j = r - b * RPB; return j < CTX ? F.in(2) + (size_t)(b * CTX + j) * DM : F.in(0) + (size_t)(b * SEQ + j - CTX) * DM; }
__device__ __forceinline__ float* xres_row(const Frame& F, int r) { const int b = r / RPB, j = r - b * RPB; return j < CTX ? F.xctx() + (size_t)(b * CTX + j) * DM : F.out() + (size_t)(b * SEQ + j - CTX) * DM; }
__device__ __forceinline__ int mod_row(int r) { const int b = r / RPB, j = r - b * RPB; return j < CTX ? 4 : b; }

namespace pg8 {
constexpr int BM = 256, BK = 64, HALF = 128, HTB = HALF * BK * 2, NXCD = 8, WGM = 8;
__device__ __forceinline__ int lds_byte(int r, int c) { const int st = (r >> 4) * 2 + (c >> 5), rr = r & 15, cc = c & 31, ob = rr * 64 + cc * 2; return st * 1024 + (ob ^ (((ob >> 9) & 1) << 5)); }
__device__ __forceinline__ void stage_rc(int b, int& R, int& C) { const int st = b / 1024, sb = b % 1024, swz = sb ^ (((sb >> 9) & 1) << 5); R = (st >> 1) * 16 + swz / 64; C = (st & 1) * 32 + (swz % 64) / 2; }
__device__ __forceinline__ int perm32(int rho) { const int n = rho >> 4, i = rho & 15; return 8 * (i >> 2) + 4 * n + (i & 3); }

struct Unit { int pm, pn, p, nrows, slot, arow0, ea, eb; };

__device__ __forceinline__ bool static_next(int i, int G, int c, int nM, int nN, int& pm, int& pn) {
    const int nwg = nM * nN; const long L = (long)i * G + c; if (L >= nwg) return false;
    int wgid = (int)L; { const int q = nwg / NXCD, r = nwg % NXCD, xcd = wgid % NXCD, off = wgid / NXCD; wgid = (xcd < r ? xcd * (q + 1) : r * (q + 1) + (xcd - r) * q) + off; }
    const int nig = WGM * nN, gid = wgid / nig, fm = gid * WGM, gsz = (nM - fm) < WGM ? (nM - fm) : WGM;
    pm = fm + ((wgid % nig) % gsz); pn = (wgid % nig) / gsz; return true;
}
struct DenseSched {
    const bf16* A; const bf16* Bt; int lda, ldb, nM, nN, G, c, a_shift, a_stride;
    __device__ __forceinline__ bool next(int i, Unit& u) const { u.p = 0; u.nrows = 256; u.slot = 0; u.arow0 = 0; u.ea = 0; u.eb = 0; return static_next(i, G, c, nM, nN, u.pm, u.pn); }
    __device__ __forceinline__ const char* a_base(const Unit& u) const { return (const char*)(A + (size_t)((u.pn >> a_shift) * a_stride)); }
    __device__ __forceinline__ unsigned a_off(const Unit& u, int row, int col) const { return (unsigned)(((u.pm * 256 + row) * lda + col) * 2); }
    __device__ __forceinline__ const char* b_tile(const Unit& u, int t) const { return (const char*)(Bt + (size_t)u.pn * 256 * ldb + (size_t)t * BK); }
};
__device__ __forceinline__ bool moe_next(int i, int G, int c, int nN, const volatile LAS int* tab, Unit& u) {
    const int total = tab[24 + NPAIR]; const int L = i * G + c; if (L >= total * nN) return false;
    const int mt = L / nN; u.pn = L - mt * nN; int p = 0;
#pragma unroll 1
    for (int q = 1; q < NPAIR; ++q) if (tab[24 + q] <= mt) p = q;
    u.p = p; u.pm = mt - tab[24 + p]; const int rem = tab[p] - u.pm * 256; u.nrows = rem < 256 ? rem : 256; u.slot = i; u.arow0 = mt * 256;
    const int g = p / 6, x = p - g * 6; const int a = x < 3 ? 0 : (x < 5 ? 1 : 2), b = x < 3 ? x + 1 : (x < 5 ? x - 1 : 3);
    u.ea = 4 * g + a; u.eb = 4 * g + b; return true;
}
struct MoeUpSched {
    const bf16* A; const bf16* Wgu; int ldb, G, c; const volatile LAS int* tab; const volatile LAS int* cidx;
    __device__ __forceinline__ bool next(int i, Unit& u) const { return moe_next(i, G, c, 12, tab, u); }
    __device__ __forceinline__ const char* a_base(const Unit&) const { return (const char*)A; }
    __device__ __forceinline__ unsigned a_off(const Unit& u, int row, int col) const { return (unsigned)((cidx[u.slot * 256 + row] * DM + col) * 2); }
    __device__ __forceinline__ const char* b_tile(const Unit& u, int t) const { const int seg = u.pn >> 2, e = seg == 0 ? 16 : (seg == 1 ? u.ea : u.eb);
        return (const char*)(Wgu + ((size_t)e * 1024 + (size_t)(u.pn & 3) * 256) * DM + (size_t)t * BK); }
};
struct MoeDownSched {
    const bf16* A; const bf16* Wd; int ldb, G, c; const volatile LAS int* tab;
    __device__ __forceinline__ bool next(int i, Unit& u) const { return moe_next(i, G, c, 8, tab, u); }
    __device__ __forceinline__ const char* a_base(const Unit&) const { return (const char*)A; }
    __device__ __forceinline__ unsigned a_off(const Unit& u, int row, int col) const { return (unsigned)(((u.arow0 + row) * NACT + col) * 2); }
    __device__ __forceinline__ const char* b_tile(const Unit& u, int t) const { const int seg = t >> 3, e = seg == 0 ? 16 : (seg == 1 ? u.ea : u.eb);
        return (const char*)(Wd + ((size_t)e * DM + (size_t)u.pn * 256) * 512 + (size_t)(t & 7) * BK); }
};

template <class Epi, class Sched, bool ALIGN_EPI>
__device__ __forceinline__ void gemm_phase(LAS unsigned char* lds, const int K, const Sched& S, const Epi& E) {
    int tid = threadIdx.x; asm volatile("" : "+v"(tid));
    const int wid = __builtin_amdgcn_readfirstlane(tid >> 6), lane = tid & 63, wr = wid >> 2, wc = wid & 3, fr = lane & 15, fq = lane >> 4;
    int nt = K / BK; asm volatile("" : "+s"(nt));
    unsigned voffB[2];
#pragma unroll
    for (int i = 0; i < 2; ++i) { int R, C; stage_rc(tid * 16 + i * 8192, R, C); const int Rb = (R & ~31) + perm32(R & 31); voffB[i] = (unsigned)(Rb * S.ldb + C) * 2u; }
    const size_t kstep = (size_t)(BK * 2);
    const size_t hstepB = (size_t)HALF * S.ldb * 2;
    const unsigned ldsw = (unsigned)wid * 1024u;
    const int aoff = lds_byte(wr * 64 + fr, fq * 8), boff = lds_byte(wc * 32 + fr, fq * 8);
#define PG8_SA(b, h) (((b) * 2 + (h)) * HTB)
#define PG8_SB(b, h) ((4 + (b) * 2 + (h)) * HTB)
#define PG8_STAGE(bufoff, gbase, voff) do { _Pragma("unroll") for (int _i = 0; _i < 2; ++_i) \
        __builtin_amdgcn_global_load_lds((const unsigned*)((const char*)(gbase) + (voff)[_i]), (LAS unsigned*)(lds + (bufoff) + ldsw + _i * 8192), 16, 0, 0); } while (0)
#define PG8_LDA(dst, b, h) do { _Pragma("unroll") for (int m = 0; m < 4; ++m) _Pragma("unroll") for (int k = 0; k < 2; ++k) dst[m][k] = *(const LAS bf16x8*)(lds + PG8_SA(b, h) + aoff + m * 2048 + k * 1024); } while (0)
#define PG8_LDB(dst, b, h) do { _Pragma("unroll") for (int n = 0; n < 2; ++n) _Pragma("unroll") for (int k = 0; k < 2; ++k) dst[n][k] = *(const LAS bf16x8*)(lds + PG8_SB(b, h) + boff + n * 2048 + k * 1024); } while (0)
#define PG8_MMA(ai, bj, At, Bt) do { __builtin_amdgcn_s_setprio(1); _Pragma("unroll") for (int m = 0; m < 4; ++m) _Pragma("unroll") for (int n = 0; n < 2; ++n) _Pragma("unroll") for (int k = 0; k < 2; ++k) \
        acc[ai][bj][m][n] = __builtin_amdgcn_mfma_f32_16x16x32_bf16(Bt[n][k], At[m][k], acc[ai][bj][m][n], 0, 0, 0); __builtin_amdgcn_s_setprio(0); } while (0)
#define PG8_WAIT_V(n) asm volatile("s_waitcnt vmcnt(" #n ")" ::: "memory")
#define PG8_WAIT_L(n) asm volatile("s_waitcnt lgkmcnt(" #n ")" ::: "memory")
#define PG8_BAR __builtin_amdgcn_s_barrier()
#define PG8_SCHED __builtin_amdgcn_sched_barrier(0)
#define PG8_AOFF(u) do { int _t = tid; asm volatile("" : "+v"(_t)); _Pragma("unroll") for (int _i = 0; _i < 2; ++_i) { int R, C; stage_rc(_t * 16 + _i * 8192, R, C); \
        oA0[_i] = S.a_off(u, R, C); oA1[_i] = S.a_off(u, HALF + R, C); } } while (0)
    Unit cur, nxt; int ui = 0;
    if (!S.next(0, cur)) return;
    f32x4 acc[2][2][4][2];
#pragma unroll
    for (int a = 0; a < 2; ++a)
#pragma unroll
        for (int b = 0; b < 2; ++b)
#pragma unroll
            for (int m = 0; m < 4; ++m)
#pragma unroll
                for (int n = 0; n < 2; ++n) acc[a][b][m][n] = (f32x4){0.f, 0.f, 0.f, 0.f};
    bf16x8 At[4][2], B0[2][2], B1[2][2];
    unsigned oA0[2], oA1[2];
    PG8_AOFF(cur);
    const char* cA = S.a_base(cur);
    {
        const char* b0 = S.b_tile(cur, 0); const char* b1 = S.b_tile(cur, 1);
        PG8_STAGE(PG8_SB(0, 0), b0, voffB); PG8_STAGE(PG8_SB(0, 1), b0 + hstepB, voffB); PG8_STAGE(PG8_SA(0, 0), cA, oA0); PG8_STAGE(PG8_SA(0, 1), cA, oA1);
        if (wr == 1) PG8_BAR;
        PG8_WAIT_V(2); PG8_BAR;
        PG8_STAGE(PG8_SB(1, 0), b1, voffB); PG8_STAGE(PG8_SA(1, 0), cA + kstep, oA0); PG8_STAGE(PG8_SB(1, 1), b1 + hstepB, voffB);
        PG8_WAIT_V(6); PG8_BAR;
    }
    for (;;) {
        const bool has_next = S.next(ui + 1, nxt);
        for (int t = 0; t < nt; t += 2) {
            const bool last = (t == nt - 2);
            const bool sw = last && has_next;
            PG8_LDB(B0, 0, 0); PG8_LDB(B1, 0, 1); PG8_SCHED; PG8_LDA(At, 0, 0); PG8_STAGE(PG8_SA(1, 1), cA + (size_t)(t + 1) * kstep, oA1);
            if (sw) { PG8_AOFF(nxt); cA = S.a_base(nxt); }
            const char* a2 = last ? cA : cA + (size_t)(t + 2) * kstep;
            const char* b2 = last ? (has_next ? S.b_tile(nxt, 0) : S.b_tile(cur, 0)) : S.b_tile(cur, t + 2);
            const char* b3 = last ? (has_next ? S.b_tile(nxt, 1) : S.b_tile(cur, 1)) : S.b_tile(cur, t + 3);
            PG8_WAIT_V(8); PG8_WAIT_L(0); PG8_BAR; PG8_MMA(0, 0, At, B0); PG8_MMA(0, 1, At, B1); PG8_BAR; PG8_SCHED;
            PG8_LDA(At, 0, 1); PG8_STAGE(PG8_SB(0, 0), b2, voffB); PG8_STAGE(PG8_SB(0, 1), b2 + hstepB, voffB); PG8_STAGE(PG8_SA(0, 0), a2, oA0);
            PG8_WAIT_V(8); PG8_WAIT_L(0); PG8_BAR; PG8_MMA(1, 0, At, B0); PG8_MMA(1, 1, At, B1); PG8_BAR; PG8_SCHED;
            PG8_LDB(B0, 1, 0); PG8_LDB(B1, 1, 1); PG8_SCHED; PG8_LDA(At, 1, 0); PG8_STAGE(PG8_SA(0, 1), a2, oA1);
            PG8_WAIT_V(8); PG8_WAIT_L(0); PG8_BAR; PG8_MMA(0, 0, At, B0); PG8_MMA(0, 1, At, B1); PG8_BAR; PG8_SCHED;
            PG8_LDA(At, 1, 1); PG8_STAGE(PG8_SB(1, 0), b3, voffB); PG8_STAGE(PG8_SB(1, 1), b3 + hstepB, voffB); PG8_STAGE(PG8_SA(1, 0), a2 + kstep, oA0);
            PG8_WAIT_V(8); PG8_WAIT_L(0); PG8_BAR; PG8_MMA(1, 0, At, B0); PG8_MMA(1, 1, At, B1); PG8_BAR; PG8_SCHED;
        }
        if constexpr (ALIGN_EPI) { if (wr == 0) PG8_BAR; }
        E(acc, cur, wr, wc, fr, fq);
        if (!has_next) break;
#pragma unroll
        for (int a = 0; a < 2; ++a)
#pragma unroll
            for (int b = 0; b < 2; ++b)
#pragma unroll
                for (int m = 0; m < 4; ++m)
#pragma unroll
                    for (int n = 0; n < 2; ++n) acc[a][b][m][n] = (f32x4){0.f, 0.f, 0.f, 0.f};
        cur = nxt; ++ui;
        if constexpr (ALIGN_EPI) { if (wr == 1) PG8_BAR; }
    }
    PG8_WAIT_V(0);
    if constexpr (!ALIGN_EPI) { if (wr == 0) PG8_BAR; }
    PG8_BAR;
#undef PG8_AOFF
#undef PG8_SA
#undef PG8_SB
#undef PG8_STAGE
#undef PG8_LDA
#undef PG8_LDB
#undef PG8_MMA
#undef PG8_WAIT_V
#undef PG8_WAIT_L
#undef PG8_BAR
#undef PG8_SCHED
}

typedef f32x4 Acc[2][2][4][2];
__device__ __forceinline__ u32x4 pack8(f32x4 v0, f32x4 v1) { u32x4 w; w.x = cvt_pk(v0[0], v0[1]); w.y = cvt_pk(v0[2], v0[3]); w.z = cvt_pk(v1[0], v1[1]); w.w = cvt_pk(v1[2], v1[3]); return w; }
__device__ __forceinline__ void unpack8(u32x4 w, f32x4& v0, f32x4& v1) { v0 = (f32x4){bflo(w.x), bfhi(w.x), bflo(w.y), bfhi(w.y)}; v1 = (f32x4){bflo(w.z), bfhi(w.z), bflo(w.w), bfhi(w.w)}; }

struct EpiP {
    bf16* O;
    __device__ __forceinline__ void operator()(const Acc& acc, const Unit& u, int wr, int wc, int fr, int fq) const {
        asm volatile("" : "+v"(fr), "+v"(fq));
        const int row0 = u.pm * BM + wr * 64 + fr, col0 = u.pn * BM + wc * 32 + 8 * fq; const bool sg = u.pn >= 8;
#pragma unroll
        for (int ai = 0; ai < 2; ++ai)
#pragma unroll
            for (int m = 0; m < 4; ++m) { bf16* rowp = O + (size_t)(row0 + ai * HALF + m * 16) * NP + col0;
#pragma unroll
                for (int bj = 0; bj < 2; ++bj) { f32x4 v0 = acc[ai][bj][m][0], v1 = acc[ai][bj][m][1];
                    if (sg) {
#pragma unroll
                        for (int j = 0; j < 4; ++j) { v0[j] = sigmoidf_(v0[j]); v1[j] = sigmoidf_(v1[j]); } }
                    *(u32x4*)(rowp + bj * HALF) = pack8(v0, v1); } }
    }
};
struct EpiStore {
    bf16* O; int ldc;
    __device__ __forceinline__ void operator()(const Acc& acc, const Unit& u, int wr, int wc, int fr, int fq) const {
        asm volatile("" : "+v"(fr), "+v"(fq));
        const int row0 = u.pm * BM + wr * 64 + fr, col0 = u.pn * BM + wc * 32 + 8 * fq;
#pragma unroll
        for (int ai = 0; ai < 2; ++ai)
#pragma unroll
            for (int m = 0; m < 4; ++m) { bf16* rowp = O + (size_t)(row0 + ai * HALF + m * 16) * ldc + col0;
#pragma unroll
                for (int bj = 0; bj < 2; ++bj) *(u32x4*)(rowp + bj * HALF) = pack8(acc[ai][bj][m][0], acc[ai][bj][m][1]); }
    }
};
struct EpiQ {
    bf16* O; const float* cosT; const float* sinT;
    __device__ __forceinline__ void operator()(const Acc& acc, const Unit& u, int wr, int wc, int fr, int fq) const {
        asm volatile("" : "+v"(fr), "+v"(fq));
        const int row0 = u.pm * BM + wr * 64 + fr, col0 = u.pn * BM + wc * 32 + 8 * fq;
        const int jt = u.pm % 17; const bool lat = jt != 0; const int pos0 = (jt - 1) * 256 + wr * 64 + fr;
#pragma unroll
        for (int bj = 0; bj < 2; ++bj) { const int c = col0 + bj * HALF, d = c % 192; const bool pe = lat && d >= 128; const int i0 = (d - 128) >> 1;
#pragma unroll
            for (int ai = 0; ai < 2; ++ai)
#pragma unroll
                for (int m = 0; m < 4; ++m) { f32x4 v0 = acc[ai][bj][m][0], v1 = acc[ai][bj][m][1];
                    if (pe) { const int pos = pos0 + ai * HALF + m * 16; const f32x4 cs = *(const f32x4*)(cosT + pos * 32 + i0), sn = *(const f32x4*)(sinT + pos * 32 + i0);
                        f32x4 r0, r1;
                        r0[0] = v0[0] * cs[0] - v0[1] * sn[0]; r0[1] = v0[1] * cs[0] + v0[0] * sn[0]; r0[2] = v0[2] * cs[1] - v0[3] * sn[1]; r0[3] = v0[3] * cs[1] + v0[2] * sn[1];
                        r1[0] = v1[0] * cs[2] - v1[1] * sn[2]; r1[1] = v1[1] * cs[2] + v1[0] * sn[2]; r1[2] = v1[2] * cs[3] - v1[3] * sn[3]; r1[3] = v1[3] * cs[3] + v1[2] * sn[3];
                        v0 = r0; v1 = r1; }
                    *(u32x4*)(O + (size_t)(row0 + ai * HALF + m * 16) * NQ + c) = pack8(v0, v1); } }
    }
};
struct EpiPool {
    bf16* O; const bf16* P; const float* pscale;
    __device__ __forceinline__ void operator()(const Acc& acc, const Unit& u, int wr, int wc, int fr, int fq) const {
        asm volatile("" : "+v"(fr), "+v"(fq));
        const int row0 = u.pm * BM + wr * 64 + fr, col0 = u.pn * BM + wc * 32 + 8 * fq;
#pragma unroll
        for (int bj = 0; bj < 2; ++bj) { const int c = col0 + bj * HALF; const f32x4 s0 = *(const f32x4*)(pscale + c), s1 = *(const f32x4*)(pscale + c + 4);
#pragma unroll
            for (int ai = 0; ai < 2; ++ai) {
#pragma unroll
                for (int m = 0; m < 4; ++m) { const size_t r = (size_t)(row0 + ai * HALF + m * 16); f32x4 g0, g1; unpack8(*(const u32x4*)(P + r * NP + P_GP + c), g0, g1);
                    *(u32x4*)(O + r * DM + c) = pack8(acc[ai][bj][m][0] * s0 * g0, acc[ai][bj][m][1] * s1 * g1); } asm volatile("" ::: "memory"); } }
    }
};
struct EpiRes {
    const Frame* F; bool first; const float* gate;
    __device__ __forceinline__ void operator()(const Acc& acc, const Unit& u, int wr, int wc, int fr, int fq) const {
        asm volatile("" : "+v"(fr), "+v"(fq));
        const int row0 = u.pm * BM + wr * 64 + fr, col0 = u.pn * BM + wc * 32 + 8 * fq; const float* gr = gate + (size_t)mod_row(u.pm * BM) * NMOD;
#pragma unroll
        for (int bj = 0; bj < 2; ++bj) { const int c = col0 + bj * HALF; const f32x4 g0 = *(const f32x4*)(gr + c), g1 = *(const f32x4*)(gr + c + 4);
#pragma unroll
            for (int ai = 0; ai < 2; ++ai)
#pragma unroll
                for (int m = 0; m < 4; ++m) { const int r = row0 + ai * HALF + m * 16; const float* src = (first ? xin_row(*F, r) : (const float*)xres_row(*F, r)) + c; float* dst = xres_row(*F, r) + c;
                    const f32x4 x0 = *(const f32x4*)src, x1 = *(const f32x4*)(src + 4);
                    *(f32x4*)dst = x0 + g0 * acc[ai][bj][m][0]; *(f32x4*)(dst + 4) = x1 + g1 * acc[ai][bj][m][1]; if (m & 1) asm volatile("" ::: "memory"); } }
    }
};
struct EpiUp {
    bf16* Act; const volatile LAS float* cwa; const volatile LAS float* cwb;
    __device__ __forceinline__ void operator()(const Acc& acc, const Unit& u, int wr, int wc, int fr, int fq) const {
        asm volatile("" : "+v"(fr), "+v"(fq));
        const int seg = u.pn >> 2, lrow0 = wr * 64 + fr, hid0 = (u.pn & 3) * 128 + wc * 16 + 4 * fq;
#pragma unroll
        for (int ai = 0; ai < 2; ++ai)
#pragma unroll
            for (int m = 0; m < 4; ++m) { const int lr = lrow0 + ai * HALF + m * 16; const float w = seg == 0 ? 1.f : (seg == 1 ? cwa[u.slot * 256 + lr] : cwb[u.slot * 256 + lr]);
                bf16* rowp = Act + (size_t)(u.arow0 + lr) * NACT + seg * 512 + hid0;
#pragma unroll
                for (int bj = 0; bj < 2; ++bj) { const f32x4 g = acc[ai][bj][m][0], up = acc[ai][bj][m][1]; f32x4 a;
#pragma unroll
                    for (int j = 0; j < 4; ++j) a[j] = w * g[j] * sigmoidf_(g[j]) * up[j];
                    u32x2 o; o.x = cvt_pk(a[0], a[1]); o.y = cvt_pk(a[2], a[3]); *(u32x2*)(rowp + bj * 64) = o; } }
    }
};
struct EpiDown {
    const Frame* F; const float* gate; const volatile LAS int* cidx;
    __device__ __forceinline__ void operator()(const Acc& acc, const Unit& u, int wr, int wc, int fr, int fq) const {
        asm volatile("" : "+v"(fr), "+v"(fq));
        const int lrow0 = wr * 64 + fr, col0 = u.pn * BM + wc * 32 + 8 * fq;
#pragma unroll
        for (int ai = 0; ai < 2; ++ai)
#pragma unroll
            for (int m = 0; m < 4; ++m) { const int lr = lrow0 + ai * HALF + m * 16;
                if (lr < u.nrows) { const int tok = cidx[u.slot * 256 + lr]; float* xr = xres_row(*F, tok); const float* gr = gate + (size_t)mod_row(tok) * NMOD;
#pragma unroll
                    for (int bj = 0; bj < 2; ++bj) { const int c = col0 + bj * HALF; const f32x4 g0 = *(const f32x4*)(gr + c), g1 = *(const f32x4*)(gr + c + 4);
                        const f32x4 x0 = *(const f32x4*)(xr + c), x1 = *(const f32x4*)(xr + c + 4);
                        *(f32x4*)(xr + c) = x0 + g0 * acc[ai][bj][m][0]; *(f32x4*)(xr + c + 4) = x1 + g1 * acc[ai][bj][m][1]; } }
                asm volatile("" ::: "memory"); }
    }
};
}

namespace att {
constexpr int NW = 8, QBLK = 32, KVBLK = 64;
constexpr float SCALE = 0.07216878364870322f;
constexpr float THR = 8.f;
constexpr int LDQ = NQ, LDK = NKV, LDP = 64;
constexpr int SHM_V = KVBLK * 128 * 2, SHM_K = KVBLK * 128 * 2, SHM_P = KVBLK * 64 * 2;
constexpr int OFF_V = 0, OFF_K = 2 * SHM_V, OFF_P = OFF_K + 2 * SHM_K, OFF_WS = OFF_P + 2 * SHM_P;
#define KSWZ(row, colB) ((row) * 256 + ((colB) ^ (((row) & 7) << 4)))
#define PSWZ(row, colB) ((row) * 128 + ((colB) ^ (((row) & 7) << 4)))
#define SBAR() __builtin_amdgcn_sched_barrier(0)
__device__ __forceinline__ int crow(int r, int hi) { return (r & 3) + 8 * (r >> 2) + 4 * hi; }
__device__ __forceinline__ unsigned cvtpk(float lo, float hi) { unsigned r; asm volatile("v_cvt_pk_bf16_f32 %0, %1, %2" : "=v"(r) : "v"(lo), "v"(hi)); return r; }

__device__ __forceinline__ void partialSM(f32x16& p0, f32x16& p1, float& m_reg, float& mn, float& alpha) {
  constexpr float C = SCALE * 1.4426950408889634f;
  float pmax = p0[0];
#pragma unroll
  for (int r = 1; r < 16; ++r) pmax = fmaxf(pmax, p0[r]);
#pragma unroll
  for (int r = 0; r < 16; ++r) pmax = fmaxf(pmax, p1[r]);
  { auto rr = __builtin_amdgcn_permlane32_swap(__float_as_uint(pmax), __float_as_uint(pmax), false, false);
    pmax = fmaxf(__uint_as_float(rr[0]), __uint_as_float(rr[1])); }
  if (__builtin_expect(__all(pmax - m_reg <= THR / SCALE), 1)) { mn = m_reg; alpha = 1.f; }
  else { mn = fmaxf(m_reg, pmax); alpha = __builtin_amdgcn_exp2f((m_reg - mn) * C); m_reg = mn; }
  float mnC = -mn * C;
#pragma unroll
  for (int r = 0; r < 16; ++r) p0[r] = fmaf(p0[r], C, mnC);
#pragma unroll
  for (int r = 0; r < 16; ++r) p1[r] = fmaf(p1[r], C, mnC);
#pragma unroll
  for (int r = 0; r < 16; ++r) p0[r] = __builtin_amdgcn_exp2f(p0[r]);
}
__device__ __forceinline__ void finishSM(f32x16& p0, f32x16& p1, float alpha, float& l_reg, bf16x8& pa0, bf16x8& pa1, bf16x8& pa2, bf16x8& pa3) {
#pragma unroll
  for (int r = 0; r < 16; ++r) p1[r] = __builtin_amdgcn_exp2f(p1[r]);
  float ps = 0;
#pragma unroll
  for (int r = 0; r < 16; ++r) ps += p0[r];
#pragma unroll
  for (int r = 0; r < 16; ++r) ps += p1[r];
  { auto rr = __builtin_amdgcn_permlane32_swap(__float_as_uint(ps), __float_as_uint(ps), false, false);
    ps = __uint_as_float(rr[0]) + __uint_as_float(rr[1]); }
  l_reg = l_reg * alpha + ps;
#define PK4(P, BASE, OUT) do { unsigned a0 = cvtpk(P[BASE + 0], P[BASE + 1]), a1 = cvtpk(P[BASE + 2], P[BASE + 3]);   \
    unsigned b0 = cvtpk(P[BASE + 4], P[BASE + 5]), b1 = cvtpk(P[BASE + 6], P[BASE + 7]);                              \
    auto r0 = __builtin_amdgcn_permlane32_swap(a0, b0, false, false); auto r1 = __builtin_amdgcn_permlane32_swap(a1, b1, false, false); \
    u32x4 w = {r0[0], r1[0], r0[1], r1[1]}; OUT = *reinterpret_cast<bf16x8*>(&w); } while (0)
  PK4(p0, 0, pa0); PK4(p0, 8, pa1); PK4(p1, 0, pa2); PK4(p1, 8, pa3);
#undef PK4
}
__device__ __forceinline__ void qkt(f32x16& p0, f32x16& p1, const char* Ks, const char* Ps, const bf16x8* qr, int r32, int hi) {
  p0 = f32x16{}; p1 = f32x16{};
#pragma unroll
  for (int d0 = 0; d0 < 8; ++d0) { int cb = (d0 * 16 + hi * 8) * 2;
    bf16x8 b0 = *reinterpret_cast<const bf16x8*>(Ks + KSWZ(r32, cb));
    bf16x8 b1 = *reinterpret_cast<const bf16x8*>(Ks + KSWZ(32 + r32, cb));
    p0 = __builtin_amdgcn_mfma_f32_32x32x16_bf16(b0, qr[d0], p0, 0, 0, 0);
    p1 = __builtin_amdgcn_mfma_f32_32x32x16_bf16(b1, qr[d0], p1, 0, 0, 0); }
#pragma unroll
  for (int d0 = 0; d0 < 4; ++d0) { int cb = (d0 * 16 + hi * 8) * 2;
    bf16x8 b0 = *reinterpret_cast<const bf16x8*>(Ps + PSWZ(r32, cb));
    bf16x8 b1 = *reinterpret_cast<const bf16x8*>(Ps + PSWZ(32 + r32, cb));
    p0 = __builtin_amdgcn_mfma_f32_32x32x16_bf16(b0, qr[8 + d0], p0, 0, 0, 0);
    p1 = __builtin_amdgcn_mfma_f32_32x32x16_bf16(b1, qr[8 + d0], p1, 0, 0, 0); }
}
__device__ __forceinline__ int v_st(int k, int c) { const int kk = (k & ~0xC) | ((k & 4) << 1) | ((k & 8) >> 1); return ((kk >> 3) * 4 + (c >> 5)) * 512 + ((kk & 7) * 32 + (c & 31)) * 2; }
__device__ __forceinline__ int v_rd_base(int lane) { return ((lane & 3) << 3) | (((lane >> 2) & 3) << 6) | (((lane >> 4) & 1) << 5) | (((lane >> 5) & 1) << 8); }
constexpr int v_rd_off(int d0, int ks, int half) { return d0 * 512 + ks * 4096 + half * 2048; }
template <int OFF> __device__ __forceinline__ s16x4 tr_read(int vb) {
  s16x4 r; asm volatile("ds_read_b64_tr_b16 %0, %1 offset:%2" : "=&v"(r) : "v"(vb), "i"(OFF) : "memory"); return r;
}
template <int D0> __device__ __forceinline__ void pv_one(f32x16& od, int vb, bf16x8 pa0, bf16x8 pa1, bf16x8 pa2, bf16x8 pa3) {
  const s16x4 l0 = tr_read<v_rd_off(D0, 0, 0)>(vb), h0 = tr_read<v_rd_off(D0, 0, 1)>(vb), l1 = tr_read<v_rd_off(D0, 1, 0)>(vb), h1 = tr_read<v_rd_off(D0, 1, 1)>(vb);
  const s16x4 l2 = tr_read<v_rd_off(D0, 2, 0)>(vb), h2 = tr_read<v_rd_off(D0, 2, 1)>(vb), l3 = tr_read<v_rd_off(D0, 3, 0)>(vb), h3 = tr_read<v_rd_off(D0, 3, 1)>(vb);
  asm volatile("s_waitcnt lgkmcnt(0)" ::: "memory"); SBAR();
#define PK(L, H) (bf16x8){L[0], L[1], L[2], L[3], H[0], H[1], H[2], H[3]}
  od = __builtin_amdgcn_mfma_f32_32x32x16_bf16(pa0, PK(l0, h0), od, 0, 0, 0);
  od = __builtin_amdgcn_mfma_f32_32x32x16_bf16(pa1, PK(l1, h1), od, 0, 0, 0);
  od = __builtin_amdgcn_mfma_f32_32x32x16_bf16(pa2, PK(l2, h2), od, 0, 0, 0);
  od = __builtin_amdgcn_mfma_f32_32x32x16_bf16(pa3, PK(l3, h3), od, 0, 0, 0);
#undef PK
}
__device__ __forceinline__ void pv_d0(f32x16* o, int vb, bf16x8 pa0, bf16x8 pa1, bf16x8 pa2, bf16x8 pa3) {
  pv_one<0>(o[0], vb, pa0, pa1, pa2, pa3); pv_one<1>(o[1], vb, pa0, pa1, pa2, pa3); pv_one<2>(o[2], vb, pa0, pa1, pa2, pa3); pv_one<3>(o[3], vb, pa0, pa1, pa2, pa3);
}
__device__ __forceinline__ void attn_unit(const bf16* __restrict__ Qb, const bf16* __restrict__ Kh, const bf16* __restrict__ Vh, const bf16* __restrict__ Kp,
                                          bf16* Mx, const bf16* Gt, int seq, char* lds) {
  int tid = threadIdx.x; asm volatile("" : "+v"(tid));
  const int wid = tid >> 6, lane = tid & 63, r32 = lane & 31, hi = lane >> 5;
  char* V_lds = lds + OFF_V; char* K_lds = lds + OFF_K; char* P_lds = lds + OFF_P;
  float* ws = (float*)(lds + OFF_WS) + wid * 64; float* li_l = ws; float* al_l = ws + 32;
  float m_reg = -1e30f, l_reg = 0; f32x16 o[4] = {}; bf16x8 qr[12];
  __syncthreads();
  const bf16* Qw = Qb + (long)(wid * QBLK + r32) * LDQ + hi * 8;
#pragma unroll
  for (int d0 = 0; d0 < 12; ++d0) qr[d0] = *reinterpret_cast<const bf16x8*>(Qw + d0 * 16);
  const int sr = tid >> 4, sc = (tid & 15) * 8, vst0 = v_st(sr, sc), vst1 = v_st(32 + sr, sc);
  const int pr = tid >> 3, pc = (tid & 7) * 8;
  const int vb0 = (int)(uintptr_t)V_lds + v_rd_base(lane);
#ifndef ATT_SDEPTH
#define ATT_SDEPTH 1
#endif
  struct { bf16x8 vs0, vs1, ks0, ks1, ps; } sr_[ATT_SDEPTH];
  const unsigned off0 = (unsigned)(sr * LDK + sc) * 2u, offp = (unsigned)(pr * LDP + pc) * 2u;
#define SLOAD(i, k0) do { const char* kb_ = (const char*)Kh + (size_t)(k0) * (LDK * 2); const char* vb_ = (const char*)Vh + (size_t)(k0) * (LDK * 2); \
    sr_[i].vs0 = *(const bf16x8*)(vb_ + off0); sr_[i].vs1 = *(const bf16x8*)(vb_ + 32 * LDK * 2 + off0); \
    sr_[i].ks0 = *(const bf16x8*)(kb_ + off0); sr_[i].ks1 = *(const bf16x8*)(kb_ + 32 * LDK * 2 + off0); \
    sr_[i].ps = *(const bf16x8*)((const char*)Kp + (size_t)(k0) * (LDP * 2) + offp); } while (0)
#define SWRITE(b, i) do { *(bf16x8*)(V_lds + (b) * SHM_V + vst0) = sr_[i].vs0; *(bf16x8*)(V_lds + (b) * SHM_V + vst1) = sr_[i].vs1; int kc = sc * 2;  \
    *(bf16x8*)(K_lds + (b) * SHM_K + KSWZ(sr, kc)) = sr_[i].ks0; *(bf16x8*)(K_lds + (b) * SHM_K + KSWZ(32 + sr, kc)) = sr_[i].ks1;                    \
    *(bf16x8*)(P_lds + (b) * SHM_P + PSWZ(pr, pc * 2)) = sr_[i].ps; } while (0)
#if ATT_SDEPTH == 2
#define SWAIT() asm volatile("s_waitcnt vmcnt(5)" ::: "memory")
#else
#define SWAIT() asm volatile("s_waitcnt vmcnt(0)" ::: "memory")
#endif
#define RESC(a) do { if (__any((a) < 1.f)) { if (hi == 0) al_l[r32] = (a); asm volatile("s_waitcnt lgkmcnt(0)" ::: "memory"); \
    _Pragma("unroll") for (int d = 0; d < 4; ++d) _Pragma("unroll") for (int r = 0; r < 16; ++r) o[d][r] *= al_l[crow(r, hi)]; } } while (0)
  f32x16 pA0, pA1, pB0, pB1; float mnA, mnB, alA, alB; bf16x8 pa0, pa1, pa2, pa3; const int NT = seq / KVBLK;
  constexpr int SE = 0, SO = ATT_SDEPTH - 1;
  SLOAD(SE, 0); asm volatile("s_waitcnt vmcnt(0)" ::: "memory"); SWRITE(0, SE); __syncthreads();
  qkt(pA0, pA1, K_lds, P_lds, qr, r32, hi); partialSM(pA0, pA1, m_reg, mnA, alA);
  SLOAD(SO, KVBLK); if (ATT_SDEPTH == 2 && 2 < NT) SLOAD(SE, 2 * KVBLK);
  SWAIT(); SWRITE(1, SO); __syncthreads();
  for (int j = 1; j + 1 < NT; j += 2) {
    SBAR(); qkt(pB0, pB1, K_lds + SHM_K, P_lds + SHM_P, qr, r32, hi);
    finishSM(pA0, pA1, alA, l_reg, pa0, pa1, pa2, pa3); SBAR();
    SLOAD(SO, (j + ATT_SDEPTH) * KVBLK); SBAR();
    pv_d0(o, vb0, pa0, pa1, pa2, pa3); partialSM(pB0, pB1, m_reg, mnB, alB);
    __syncthreads(); SWAIT(); SWRITE(0, SE);
    RESC(alB); __syncthreads();
    SBAR(); qkt(pA0, pA1, K_lds, P_lds, qr, r32, hi);
    finishSM(pB0, pB1, alB, l_reg, pa0, pa1, pa2, pa3); SBAR();
    if (ATT_SDEPTH == 1 || j + 3 < NT) SLOAD(SE, (j + 1 + ATT_SDEPTH) * KVBLK); SBAR();
    pv_d0(o, vb0 + (int)SHM_V, pa0, pa1, pa2, pa3); partialSM(pA0, pA1, m_reg, mnA, alA);
    __syncthreads(); SWAIT(); SWRITE(1, SO);
    RESC(alA); __syncthreads();
  }
  SBAR(); qkt(pB0, pB1, K_lds + SHM_K, P_lds + SHM_P, qr, r32, hi);
  finishSM(pA0, pA1, alA, l_reg, pa0, pa1, pa2, pa3); SBAR();
  pv_d0(o, vb0, pa0, pa1, pa2, pa3); partialSM(pB0, pB1, m_reg, mnB, alB);
  __syncthreads(); RESC(alB);
  finishSM(pB0, pB1, alB, l_reg, pa0, pa1, pa2, pa3); SBAR();
  pv_d0(o, vb0 + (int)SHM_V, pa0, pa1, pa2, pa3);
  if (hi == 0) li_l[r32] = l_reg; asm volatile("s_waitcnt lgkmcnt(0)" ::: "memory");
  float rli[16];
#pragma unroll
  for (int r = 0; r < 16; ++r) rli[r] = __builtin_amdgcn_rcpf(li_l[crow(r, hi)]);
  __syncthreads();
  float* ep = (float*)(lds + wid * (32 * 132 * 4));
#pragma unroll
  for (int r = 0; r < 16; ++r)
#pragma unroll
    for (int d0 = 0; d0 < 4; ++d0) ep[crow(r, hi) * 132 + d0 * 32 + r32] = o[d0][r] * rli[r];
  asm volatile("s_waitcnt lgkmcnt(0)" ::: "memory");
  int lane2 = lane; asm volatile("" : "+v"(lane2));
#pragma unroll 2
  for (int it = 0; it < 8; ++it) { const int item = it * 64 + lane2, row = item >> 4, ch = item & 15; const long orow = wid * QBLK + row;
    const f32x4 y0 = *(const f32x4*)(ep + row * 132 + ch * 8), y1 = *(const f32x4*)(ep + row * 132 + ch * 8 + 4);
    f32x4 g0, g1, m0, m1; pg8::unpack8(*(const u32x4*)(Gt + orow * NP + ch * 8), g0, g1); pg8::unpack8(*(const u32x4*)(Mx + orow * DM + ch * 8), m0, m1);
    *(u32x4*)(Mx + orow * DM + ch * 8) = pg8::pack8(g0 * y0 + m0, g1 * y1 + m1); }
#undef SLOAD
#undef SWRITE
#undef SWAIT
#undef RESC
}
}

__device__ __forceinline__ int srccol(int kind, int n) {
    if (kind == 1) { if (n < 512) return n; if (n < 896) return 576 + (n - 512); if (n < 960) return 512 + (n - 896); if (n < 1024) return -1; if (n < 2048) return 960 + (n - 1024); return 1984 + (n - 2048); }
    if (kind == 2) { const int h = n / 192, d = n - h * 192; if (d < 128) return n; const int p = d - 128; return h * 192 + 128 + ((p & 1) ? 32 + (p >> 1) : (p >> 1)); }
    return n;
}
__device__ __forceinline__ void transpose_item(const float* W, const float* W2, int K, int srcN, int kind, bf16* WT, LAS float* scr, int item, int nblk, int lane) {
    const int kb = item / nblk, nb = item - kb * nblk, k0 = 64 * kb, n0 = 32 * nb;
    const int n = n0 + (lane & 31); const float* src = W; int sc;
    if (kind == 3) { const int q = n >> 3, w = n & 7; src = (w < 4) ? W : W2; sc = 4 * q + (w & 3); } else sc = srccol(kind, n);
#pragma unroll 8
    for (int i = 0; i < 32; ++i) { const int kk = 2 * i + (lane >> 5); scr[kk * 33 + (lane & 31)] = sc >= 0 ? src[(size_t)(k0 + kk) * srcN + sc] : 0.f; }
    LDS_WAIT(); asm volatile("" ::: "memory");
    const int c = lane & 7;
#pragma unroll
    for (int j = 0; j < 4; ++j) { const int nn = (lane >> 3) + 8 * j; const LAS float* s = scr + (8 * c) * 33 + nn;
        u32x4 o; o.x = cvt_pk(s[0 * 33], s[1 * 33]); o.y = cvt_pk(s[2 * 33], s[3 * 33]); o.z = cvt_pk(s[4 * 33], s[5 * 33]); o.w = cvt_pk(s[6 * 33], s[7 * 33]);
        *(u32x4*)(WT + (size_t)(n0 + nn) * K + k0 + 8 * c) = o; }
    LDS_WAIT(); asm volatile("" ::: "memory");
}
constexpr int IT_IN = (DM / 64) * (NP / 32), IT_KVB = (512 / 64) * (NKV / 32), IT_QB = (384 / 64) * (NQ / 32), IT_POOL1 = (256 / 64) * (512 / 32), IT_OUT = (DM / 64) * (DM / 32),
              IT_GU1 = (DM / 64) * (1024 / 32), IT_D1 = (512 / 64) * (DM / 32);
constexpr int ITO_KVB = IT_IN, ITO_QB = ITO_KVB + IT_KVB, ITO_POOL = ITO_QB + IT_QB, ITO_OUT = ITO_POOL + 4 * IT_POOL1, ITO_GU = ITO_OUT + IT_OUT, ITO_D = ITO_GU + 17 * IT_GU1, IT_LAYER = ITO_D + 17 * IT_D1;

__device__ __forceinline__ void p0_prologue(Frame& F) {
    {
        LAS float* sil = (LAS float*)F.lds;
        LAS float* red = (LAS float*)(F.lds + 40960);
        for (int q = F.tid; q < 5 * DM; q += 512) { const int i = q / DM, k = q - i * DM; const float v = i < 4 ? F.in(1)[i * DM + k] : F.in(3)[k]; sil[q] = v * sigmoidf_(v); }
        __syncthreads();
        const int tx = F.tid & 31, ty = F.tid >> 5;
        for (int it = F.vcu; it < 2 * 96; it += F.G) {
            const int l = it / 96, c0 = (it - l * 96) * 128;
            const float* wp = F.in(4) + (size_t)l * DM * NMOD + c0 + 4 * tx;
            f32x4 a0 = {0, 0, 0, 0}, a1 = a0, a2 = a0, a3 = a0, a4 = a0;
#pragma unroll 8
            for (int r = ty; r < DM; r += 16) { const f32x4 w = *(const f32x4*)(wp + (size_t)r * NMOD);
                a0 += sil[r] * w; a1 += sil[DM + r] * w; a2 += sil[2 * DM + r] * w; a3 += sil[3 * DM + r] * w; a4 += sil[4 * DM + r] * w; }
            LAS f32x4* rp = (LAS f32x4*)red + (ty * 5) * 32 + tx;
            rp[0] = a0; rp[32] = a1; rp[64] = a2; rp[96] = a3; rp[128] = a4;
            __syncthreads();
            if (F.tid < 160) { const int i = F.tid >> 5; f32x4 s = *(const f32x4*)(F.in(5) + (size_t)l * NMOD + c0 + 4 * tx);
#pragma unroll
                for (int y = 0; y < 16; ++y) s += ((LAS f32x4*)red)[(y * 5 + i) * 32 + tx];
                *(f32x4*)(F.mod() + ((size_t)l * 5 + i) * NMOD + c0 + 4 * tx) = s; }
            __syncthreads();
        }
    }
    for (int q = F.vcu * 512 + F.tid; q < SEQ * 32; q += F.G * 512) { const int pos = q >> 5, i = q & 31;
        const float inv = __builtin_amdgcn_exp2f(-(float)(i & 15) * 0.830482023721841f);
        const float ang = (float)(i < 16 ? (pos >> 6) : (pos & 63)) * inv; const float rev = ang * 0.15915494309189535f; const float fr = rev - floorf(rev);
        F.cosT()[q] = __builtin_amdgcn_cosf(fr); F.sinT()[q] = __builtin_amdgcn_sinf(fr); }
    LAS float* scr = (LAS float*)(F.lds + F.wave * 16384);
    const int gw = F.vcu * NWAVES + F.wave, NGW = F.G * NWAVES;
    for (int it = gw; it < DEPTH * IT_LAYER; it += NGW) {
        const int l = it / IT_LAYER; int r = it - l * IT_LAYER; bf16* wl = (bf16*)(F.ws() + WS_W + (size_t)l * LW_BYTES);
        if (r < ITO_KVB) { transpose_item(F.in(8) + (size_t)l * DM * IN_COLS, nullptr, DM, IN_COLS, 1, (bf16*)((char*)wl + LW_IN), scr, r, NP / 32, F.lane); continue; }
        if (r < ITO_QB) { transpose_item(F.in(12) + (size_t)l * 512 * NKV, nullptr, 512, NKV, 0, (bf16*)((char*)wl + LW_KVB), scr, r - ITO_KVB, NKV / 32, F.lane); continue; }
        if (r < ITO_POOL) { transpose_item(F.in(11) + (size_t)l * 384 * NQ, nullptr, 384, NQ, 2, (bf16*)((char*)wl + LW_QB), scr, r - ITO_QB, NQ / 32, F.lane); continue; }
        if (r < ITO_OUT) { r -= ITO_POOL; const int g = r / IT_POOL1; transpose_item(F.in(13) + (size_t)(l * 4 + g) * 256 * 512, nullptr, 256, 512, 0, (bf16*)((char*)wl + LW_POOL) + (size_t)g * 512 * 256, scr, r - g * IT_POOL1, 512 / 32, F.lane); continue; }
        if (r < ITO_GU) { transpose_item(F.in(15) + (size_t)l * DM * DM, nullptr, DM, DM, 0, (bf16*)((char*)wl + LW_OUT), scr, r - ITO_OUT, DM / 32, F.lane); continue; }
        if (r < ITO_D) { r -= ITO_GU; const int e = r / IT_GU1;
            const float* wg = e < 16 ? F.in(18) + (size_t)(l * 16 + e) * DM * 512 : F.in(21) + (size_t)l * DM * 512;
            const float* wu = e < 16 ? F.in(19) + (size_t)(l * 16 + e) * DM * 512 : F.in(22) + (size_t)l * DM * 512;
            transpose_item(wg, wu, DM, 512, 3, (bf16*)((char*)wl + LW_GU) + (size_t)e * 1024 * DM, scr, r - e * IT_GU1, 1024 / 32, F.lane); continue; }
        { r -= ITO_D; const int e = r / IT_D1;
            const float* wd = e < 16 ? F.in(20) + (size_t)(l * 16 + e) * 512 * DM : F.in(23) + (size_t)l * 512 * DM;
            transpose_item(wd, nullptr, 512, DM, 0, (bf16*)((char*)wl + LW_D) + (size_t)e * DM * 512, scr, r - e * IT_D1, DM / 32, F.lane); }
    }
}

__device__ __forceinline__ void t1_phase(Frame& F, int l) {
    const int gw = F.vcu * NWAVES + F.wave, NGW = F.G * NWAVES;
    const float* gn = F.in(6) + (size_t)l * DM;
    for (int r = gw; r < T; r += NGW) {
        const float* xr = (l == 0) ? xin_row(F, r) : (const float*)xres_row(F, r);
        const float* md = F.mod() + ((size_t)l * 5 + mod_row(r)) * NMOD;
        f32x4 v[8]; float ss = 0.f;
#pragma unroll
        for (int j = 0; j < 8; ++j) { v[j] = *(const f32x4*)(xr + 256 * j + 4 * F.lane); ss += (v[j][0] * v[j][0] + v[j][1] * v[j][1]) + (v[j][2] * v[j][2] + v[j][3] * v[j][3]); }
        const float rinv = rsqrtf(wave_sum(ss) * (1.f / DM) + EPS);
        bf16* orow = F.HM() + (size_t)r * DM;
#pragma unroll
        for (int j = 0; j < 8; ++j) { const int c = 256 * j + 4 * F.lane; const f32x4 g = *(const f32x4*)(gn + c), sh = *(const f32x4*)(md + c), sc = *(const f32x4*)(md + DM + c);
            const f32x4 y = (v[j] * rinv * g) * (1.f + sc) + sh; u32x2 o; o.x = cvt_pk(y[0], y[1]); o.y = cvt_pk(y[2], y[3]); *(u32x2*)(orow + c) = o; }
    }
}
__device__ __forceinline__ void t2_phase(Frame& F, int l) {
    const int gw = F.vcu * NWAVES + F.wave, NGW = F.G * NWAVES, lane = F.lane;
    const float* gkv = F.in(10) + (size_t)l * 512; const float* gq = F.in(9) + (size_t)l * 384;
    for (int r = gw; r < T; r += NGW) {
        const int b = r / RPB, j = r - b * RPB; const bool isctx = j < CTX;
        bf16* prow = F.P() + (size_t)r * NP;
        {
            f32x4 v0, v1; pg8::unpack8(*(const u32x4*)(prow + lane * 8), v0, v1);
            float ss = (v0[0] * v0[0] + v0[1] * v0[1]) + (v0[2] * v0[2] + v0[3] * v0[3]) + (v1[0] * v1[0] + v1[1] * v1[1]) + (v1[2] * v1[2] + v1[3] * v1[3]);
            const float rinv = rsqrtf(wave_sum(ss) * (1.f / 512) + EPS);
            const f32x4 g0 = *(const f32x4*)(gkv + lane * 8), g1 = *(const f32x4*)(gkv + lane * 8 + 4);
            *(u32x4*)(prow + lane * 8) = pg8::pack8(v0 * rinv * g0, v1 * rinv * g1);
        }
        {
            const bool act = lane < 48; f32x4 v0 = {0, 0, 0, 0}, v1 = v0;
            if (act) pg8::unpack8(*(const u32x4*)(prow + P_Q + lane * 8), v0, v1);
            float ss = (v0[0] * v0[0] + v0[1] * v0[1]) + (v0[2] * v0[2] + v0[3] * v0[3]) + (v1[0] * v1[0] + v1[1] * v1[1]) + (v1[2] * v1[2] + v1[3] * v1[3]);
            const float rinv = rsqrtf(wave_sum(ss) * (1.f / 384) + EPS);
            if (act) { const f32x4 g0 = *(const f32x4*)(gq + lane * 8), g1 = *(const f32x4*)(gq + lane * 8 + 4);
                *(u32x4*)(prow + P_Q + lane * 8) = pg8::pack8(v0 * rinv * g0, v1 * rinv * g1); }
        }
        if (lane < 32) {
            float x1 = bf2f(prow[P_KPE + lane]), x2 = bf2f(prow[P_KPE + 32 + lane]);
            if (!isctx) { const int pos = j - CTX; const float cs = F.cosT()[pos * 32 + lane], sn = F.sinT()[pos * 32 + lane]; const float y1 = x1 * cs - x2 * sn, y2 = x2 * cs + x1 * sn; x1 = y1; x2 = y2; }
            ((unsigned*)(F.KPE() + (size_t)r * 64))[lane] = cvt_pk(x1, x2);
        }
        {
            const int seg0 = b * RPB + (isctx ? 0 : CTX), n = isctx ? CTX : SEQ, t = isctx ? j : j - CTX;
#pragma unroll
            for (int h2 = 0; h2 < 2; ++h2) { const int ch = lane + 64 * h2, g = ch >> 5, half = 1 << g;
                const int lo = t - half < 0 ? 0 : t - half, hi = t + half > n ? n : t + half;
                const bf16* pc = F.P() + (size_t)seg0 * NP + P_POOL + ch * 8;
                f32x4 s0 = {0, 0, 0, 0}, s1 = s0;
                for (int q = lo; q < hi; ++q) { f32x4 a0, a1; pg8::unpack8(*(const u32x4*)(pc + (size_t)q * NP), a0, a1); s0 += a0; s1 += a1; }
                f32x4 u0, u1; pg8::unpack8(*(const u32x4*)(pc + (size_t)t * NP), u0, u1);
                const float rc = 1.f / (float)(hi - lo);
                *(u32x4*)(F.Z() + (size_t)r * NZ + ch * 8) = pg8::pack8(s0 * rc - u0, s1 * rc - u1); }
        }
    }
}
__device__ __forceinline__ void t3_phase(Frame& F, int l) {
    const bool lastl = (l == DEPTH - 1);
    LAS float* wrT = (LAS float*)F.lds;
    volatile LAS int* rec = (volatile LAS int*)(F.ldsx + L_CIDX);
    for (int q = F.tid; q < DM * 16; q += 512) { const int k = q >> 4, e = q & 15; wrT[e * DM + k] = F.in(16)[q]; }
    if (F.tid == 0) rec[0] = 0;
    __syncthreads();
    const int gw = F.vcu * NWAVES + F.wave, NGW = F.G * NWAVES, lane = F.lane;
    const float* gn = F.in(7) + (size_t)l * DM;
    float bias[16];
#pragma unroll
    for (int e = 0; e < 16; ++e) bias[e] = F.in(17)[e];
    for (int r = gw; r < T; r += NGW) {
        const int b = r / RPB, j = r - b * RPB; if (lastl && j < CTX) continue;
        const float* xr = xres_row(F, r);
        const float* md = F.mod() + ((size_t)l * 5 + (j < CTX ? 4 : b)) * NMOD + 3 * DM;
        f32x4 v[8]; float ss = 0.f;
#pragma unroll
        for (int jj = 0; jj < 8; ++jj) { v[jj] = *(const f32x4*)(xr + 256 * jj + 4 * lane); ss += (v[jj][0] * v[jj][0] + v[jj][1] * v[jj][1]) + (v[jj][2] * v[jj][2] + v[jj][3] * v[jj][3]); }
        const float rinv = rsqrtf(wave_sum(ss) * (1.f / DM) + EPS);
        bf16* orow = F.HM() + (size_t)r * DM;
#pragma unroll
        for (int jj = 0; jj < 8; ++jj) { const int c = 256 * jj + 4 * lane; const f32x4 g = *(const f32x4*)(gn + c), sh = *(const f32x4*)(md + c), sc = *(const f32x4*)(md + DM + c);
            v[jj] = (v[jj] * rinv * g) * (1.f + sc) + sh; u32x2 o; o.x = cvt_pk(v[jj][0], v[jj][1]); o.y = cvt_pk(v[jj][2], v[jj][3]); *(u32x2*)(orow + c) = o; }
        float lg[16];
#pragma unroll
        for (int e = 0; e < 16; ++e) { float s = 0.f;
#pragma unroll
            for (int jj = 0; jj < 8; ++jj) { const f32x4 w = *(const LAS f32x4*)(wrT + e * DM + 256 * jj + 4 * lane); s += (v[jj][0] * w[0] + v[jj][1] * w[1]) + (v[jj][2] * w[2] + v[jj][3] * w[3]); }
            lg[e] = wave_sum(s); }
        float sc_[16], sel[16];
#pragma unroll
        for (int e = 0; e < 16; ++e) { sc_[e] = 1.f / (1.f + expf(-lg[e])); sel[e] = sc_[e] + bias[e]; }
        int bg = 0; float bgs = -1e30f;
#pragma unroll
        for (int g = 0; g < 4; ++g) { float m1 = -1e30f, m2 = -1e30f;
#pragma unroll
            for (int k = 0; k < 4; ++k) { const float x = sel[4 * g + k]; if (x > m1) { m2 = m1; m1 = x; } else if (x > m2) m2 = x; }
            const float gs = m1 + m2; if (gs > bgs) { bgs = gs; bg = g; } }
        float s4[4], q4[4];
#pragma unroll
        for (int k = 0; k < 4; ++k) { s4[k] = bg == 0 ? sel[k] : (bg == 1 ? sel[4 + k] : (bg == 2 ? sel[8 + k] : sel[12 + k])); q4[k] = bg == 0 ? sc_[k] : (bg == 1 ? sc_[4 + k] : (bg == 2 ? sc_[8 + k] : sc_[12 + k])); }
        int i1 = 0; float m1 = s4[0];
#pragma unroll
        for (int k = 1; k < 4; ++k) if (s4[k] > m1) { m1 = s4[k]; i1 = k; }
        int i2 = -1; float m2 = -1e30f;
#pragma unroll
        for (int k = 0; k < 4; ++k) if (k != i1 && s4[k] > m2) { m2 = s4[k]; i2 = k; }
        const float w1 = i1 == 0 ? q4[0] : (i1 == 1 ? q4[1] : (i1 == 2 ? q4[2] : q4[3])), w2 = i2 == 0 ? q4[0] : (i2 == 1 ? q4[1] : (i2 == 2 ? q4[2] : q4[3]));
        const float ws_ = 1.f / (w1 + w2);
        const int a = i1 < i2 ? i1 : i2, bb = i1 < i2 ? i2 : i1; const float wa = (i1 < i2 ? w1 : w2) * ws_, wb = (i1 < i2 ? w2 : w1) * ws_;
        const int pidx = a == 0 ? bb - 1 : (a == 1 ? bb + 1 : 5); const int pair = bg * 6 + pidx;
        if (lane == 0) { const int k = __hip_atomic_fetch_add((LAS int*)rec, 1, __ATOMIC_RELAXED, __HIP_MEMORY_SCOPE_WORKGROUP);
            rec[4 + 4 * k] = r; rec[5 + 4 * k] = pair; rec[6 + 4 * k] = __float_as_int(wa); rec[7 + 4 * k] = __float_as_int(wb); }
    }
    __syncthreads();
    {
        volatile LAS int* base = (volatile LAS int*)(F.ldsx + L_TAB);
        const int nrec = rec[0];
        if (F.tid < NPAIR) { int c = 0; for (int k = 0; k < nrec; ++k) c += (rec[5 + 4 * k] == F.tid) ? 1 : 0;
            base[F.tid] = c ? (int)__hip_atomic_fetch_add(F.ctl() + CW_CNT + (l * NPAIR + F.tid) * 64, (unsigned)c, __ATOMIC_RELAXED, __HIP_MEMORY_SCOPE_AGENT) : 0; }
        __syncthreads();
        if (F.tid < nrec) { const int k = F.tid, pair = rec[5 + 4 * k]; int rank = 0; for (int q = 0; q < k; ++q) rank += (rec[5 + 4 * q] == pair) ? 1 : 0;
            const size_t dst = (size_t)pair * T + base[pair] + rank;
            F.ltok()[dst] = rec[4 + 4 * k]; F.lwa()[dst] = __int_as_float(rec[6 + 4 * k]); F.lwb()[dst] = __int_as_float(rec[7 + 4 * k]); }
    }
    __syncthreads();
}
__device__ __forceinline__ void moe_setup(Frame& F, int l, int nN) {
    volatile LAS int* tab = (volatile LAS int*)(F.ldsx + L_TAB);
    volatile LAS int* cidx = (volatile LAS int*)(F.ldsx + L_CIDX); volatile LAS float* cwa = (volatile LAS float*)(F.ldsx + L_CWA); volatile LAS float* cwb = (volatile LAS float*)(F.ldsx + L_CWB);
    __syncthreads();
    if (F.tid < NPAIR) tab[F.tid] = (int)__hip_atomic_load(F.ctl() + CW_CNT + (l * NPAIR + F.tid) * 64, __ATOMIC_RELAXED, __HIP_MEMORY_SCOPE_AGENT);
    __syncthreads();
    if (F.tid == 0) { int s = 0; for (int p = 0; p < NPAIR; ++p) { tab[24 + p] = s; s += (tab[p] + 255) >> 8; } tab[24 + NPAIR] = s; }
    __syncthreads();
    const int total = tab[24 + NPAIR] * nN;
    for (int q = F.tid; q < MAXU * 256; q += 512) { const int i = q >> 8, row = q & 255; const int L = i * F.G + F.bx;
        int tok = 0; float wa = 0.f, wb = 0.f;
        if (L < total) { const int mt = L / nN; int p = 0; for (int k = 1; k < NPAIR; ++k) if (tab[24 + k] <= mt) p = k;
            const int lr = (mt - tab[24 + p]) * 256 + row; if (lr < tab[p]) { const size_t s = (size_t)p * T + lr; tok = F.ltok()[s]; wa = F.lwa()[s]; wb = F.lwb()[s]; } }
        cidx[q] = tok; cwa[q] = wa; cwb[q] = wb; }
    __syncthreads();
}
__device__ __forceinline__ void final_phase(Frame& F) {
    const int gw = F.vcu * NWAVES + F.wave, NGW = F.G * NWAVES; const float* gn = F.in(24);
    for (int r = gw; r < NBATCH * SEQ; r += NGW) { float* xr = F.out() + (size_t)r * DM;
        f32x4 v[8]; float ss = 0.f;
#pragma unroll
        for (int j = 0; j < 8; ++j) { v[j] = *(const f32x4*)(xr + 256 * j + 4 * F.lane); ss += (v[j][0] * v[j][0] + v[j][1] * v[j][1]) + (v[j][2] * v[j][2] + v[j][3] * v[j][3]); }
        const float rinv = rsqrtf(wave_sum(ss) * (1.f / DM) + EPS);
#pragma unroll
        for (int j = 0; j < 8; ++j) { const int c = 256 * j + 4 * F.lane; *(f32x4*)(xr + c) = v[j] * rinv * *(const f32x4*)(gn + c); } }
}

constexpr int NPHASE = 20;
__global__ void __launch_bounds__(NWAVES * 64, 2) fwd(Args args) {
    extern __shared__ __attribute__((aligned(16))) unsigned char lds[];
    Frame F; F.lds = (LAS unsigned char*)lds; F.fresh();
    volatile LAS unsigned* MISC = (volatile LAS unsigned*)(F.lds + L_MISC);
    if (F.tid < 128) MISC[F.tid] = 0u;
    __syncthreads();
    const int lo = args.ph_lo, hi = args.ph_hi;
    const bool multi = (hi - lo) > 1;
    if (multi) (void)xcd_barrier_post(F.ctl() + CW_BAR, MISC + 8);
#ifndef ONLY_PH
#define ONLY_PH -1
#endif
#define SEL(kind) (ONLY_PH < 0 || ONLY_PH == (kind))
#define IN(k) (lo <= (k) && (k) < hi)
#define SEAM(k) do { if (IN(k) && IN((k) + 1)) { F.fresh(); XcdBarrier b_; b_.bar = F.ctl() + CW_BAR; b_.x = xb_xcc_id(); b_.st = MISC + 8; xcd_barrier(b_); } } while (0)

    if (SEL(0) && IN(0)) { F.fresh(); p0_prologue(F); __syncthreads(); SEAM(0); }

    for (int l = 0; l < DEPTH; ++l) {
        const int pb = 1 + 9 * l;
#define WL (F.ws() + WS_W + (size_t)l * LW_BYTES)
#define MODL (F.mod() + (size_t)l * 5 * NMOD)
        if (SEL(1) && IN(pb + 0)) { F.fresh(); t1_phase(F, l); SEAM(pb + 0); }
        if (SEL(2) && IN(pb + 1)) { F.fresh();
            pg8::DenseSched S{F.HM(), (const bf16*)(WL + LW_IN), DM, DM, T / 256, NP / 256, F.G, F.bx, 0, 0};
            pg8::EpiP E{F.P()};
            pg8::gemm_phase<pg8::EpiP, pg8::DenseSched, true>(F.lds, DM, S, E);
            SEAM(pb + 1);
        }
        if (SEL(3) && IN(pb + 2)) { F.fresh(); t2_phase(F, l); SEAM(pb + 2); }
        if (SEL(4) && IN(pb + 3)) { F.fresh();
#ifndef SUB_B
#define SUB_B 7
#endif
            if (SUB_B & 1) { pg8::DenseSched S{F.P(), (const bf16*)(WL + LW_KVB), NP, 512, T / 256, NKV / 256, F.G, F.bx, 0, 0};
              pg8::EpiStore E{F.KV(), NKV};
              pg8::gemm_phase<pg8::EpiStore, pg8::DenseSched, true>(F.lds, 512, S, E); }
            if (SUB_B & 2) { pg8::DenseSched S{F.P() + P_Q, (const bf16*)(WL + LW_QB), NP, 384, T / 256, NQ / 256, F.G, F.bx, 0, 0};
              pg8::EpiQ E{F.Q(), F.cosT(), F.sinT()};
              pg8::gemm_phase<pg8::EpiQ, pg8::DenseSched, true>(F.lds, 384, S, E); }
            if (SUB_B & 4) { pg8::DenseSched S{F.Z(), (const bf16*)(WL + LW_POOL), NZ, 256, T / 256, DM / 256, F.G, F.bx, 1, 256};
              pg8::EpiPool E{F.HM(), F.P(), F.in(14) + (size_t)l * DM};
              pg8::gemm_phase<pg8::EpiPool, pg8::DenseSched, true>(F.lds, 256, S, E); }
            SEAM(pb + 3);
        }
        if (SEL(5) && IN(pb + 4)) { F.fresh();
            const int nunits = NBATCH * NH * 16 + (l == 0 ? NBATCH * NH : 0);
            for (int i = 0;; ++i) { const int L = i * F.G + F.vcu; if (L >= nunits) break;
                int b, h, q0, seq;
                if (L < NBATCH * NH * 16) { const int bh = L >> 4, qb = L & 15; b = bh >> 4; h = bh & 15; q0 = b * RPB + CTX + qb * 256; seq = RPB; }
                else { const int bh = L - NBATCH * NH * 16; b = bh >> 4; h = bh & 15; q0 = b * RPB; seq = CTX; }
                const size_t k0 = (size_t)b * RPB;
                att::attn_unit(F.Q() + (size_t)q0 * NQ + h * 192, F.KV() + k0 * NKV + h * 256, F.KV() + k0 * NKV + h * 256 + 128, F.KPE() + k0 * 64,
                               F.HM() + (size_t)q0 * DM + h * 128, F.P() + (size_t)q0 * NP + P_GM + h * 128, seq, (char*)lds); }
            __syncthreads();
            SEAM(pb + 4);
        }
        if (SEL(6) && IN(pb + 5)) { F.fresh();
            pg8::DenseSched S{F.HM(), (const bf16*)(WL + LW_OUT), DM, DM, T / 256, DM / 256, F.G, F.bx, 0, 0};
            pg8::EpiRes E{&F, l == 0, MODL + 2 * DM};
            pg8::gemm_phase<pg8::EpiRes, pg8::DenseSched, true>(F.lds, DM, S, E);
            SEAM(pb + 5);
        }
        if (SEL(7) && IN(pb + 6)) { F.fresh(); t3_phase(F, l); SEAM(pb + 6); }
        if (SEL(8) && IN(pb + 7)) { F.fresh();
            moe_setup(F, l, 12);
            pg8::MoeUpSched S{F.HM(), (const bf16*)(WL + LW_GU), DM, F.G, F.bx, (const volatile LAS int*)(F.ldsx + L_TAB), (const volatile LAS int*)(F.ldsx + L_CIDX)};
            pg8::EpiUp E{F.ACT(), (const volatile LAS float*)(F.ldsx + L_CWA), (const volatile LAS float*)(F.ldsx + L_CWB)};
            pg8::gemm_phase<pg8::EpiUp, pg8::MoeUpSched, true>(F.lds, DM, S, E);
            SEAM(pb + 7);
        }
        if (SEL(9) && IN(pb + 8)) { F.fresh();
            moe_setup(F, l, 8);
            pg8::MoeDownSched S{F.ACT(), (const bf16*)(WL + LW_D), 512, F.G, F.bx, (const volatile LAS int*)(F.ldsx + L_TAB)};
            pg8::EpiDown E{&F, MODL + 5 * DM, (const volatile LAS int*)(F.ldsx + L_CIDX)};
            pg8::gemm_phase<pg8::EpiDown, pg8::MoeDownSched, true>(F.lds, NACT, S, E);
            SEAM(pb + 8);
        }
    }
    if (SEL(10) && IN(19)) { F.fresh(); final_phase(F); }
#undef IN
#undef SEAM
}

extern "C" void kernel_launch(void* const* d_in, const int* in_sizes, int n_in, void* d_out, int out_size, void* d_ws, size_t ws_size, hipStream_t stream) {
    static int grid = 0;
    if (grid == 0) {
        if (n_in != 25 || out_size != NBATCH * SEQ * DM || ws_size < WS_END) { fprintf(stderr, "kernel_launch: unexpected shapes (n_in %d out %d ws %zu)\n", n_in, out_size, ws_size); grid = -1; return; }
        int dev = 0, cus = 0;
        if (hipGetDevice(&dev) != hipSuccess || hipDeviceGetAttribute(&cus, hipDeviceAttributeMultiprocessorCount, dev) != hipSuccess) { grid = -1; return; }
        if (hipFuncSetAttribute((const void*)fwd, hipFuncAttributeMaxDynamicSharedMemorySize, LDS_BYTES) != hipSuccess) { fprintf(stderr, "kernel_launch: hipFuncSetAttribute failed\n"); grid = -1; return; }
        int per_cu = 0;
        if (hipOccupancyMaxActiveBlocksPerMultiprocessor(&per_cu, (const void*)fwd, NWAVES * 64, LDS_BYTES) != hipSuccess || per_cu < 1) { fprintf(stderr, "kernel_launch: occupancy query says %d\n", per_cu); }
        (void)hipGetLastError();
        grid = cus;
    }
    if (grid < 0) return;
    (void)hipMemsetAsync((char*)d_ws + WS_CTL, 0, CTL_ZERO_BYTES, stream);
    Args a{};
    for (int i = 0; i < 25; ++i) a.in[i] = (const float*)d_in[i];
    a.out = (float*)d_out; a.ws = (unsigned char*)d_ws;
#if MK_PER_PHASE
    for (int k = 0; k < NPHASE; ++k) { a.ph_lo = k; a.ph_hi = k + 1; hipLaunchKernelGGL(fwd, dim3(grid), dim3(NWAVES * 64), LDS_BYTES, stream, a); }
#else
    a.ph_lo = 0; a.ph_hi = NPHASE; hipLaunchKernelGGL(fwd, dim3(grid), dim3(NWAVES * 64), LDS_BYTES, stream, a);
#endif
}
```

```cpp
#include <hip/hip_runtime.h>
#include <cstdio>
#include <cstdint>

#ifndef PROBE_ATTN
#define PROBE_ATTN 0
#endif
#ifndef ATT_FP8
#define ATT_FP8 1
#endif
#ifndef MK_PER_PHASE
#define MK_PER_PHASE 0
#endif

#define LAS __attribute__((address_space(3)))
#define GAS __attribute__((address_space(1)))
typedef unsigned short bf16;
typedef short bf16x8 __attribute__((ext_vector_type(8)));
typedef short s16x4 __attribute__((ext_vector_type(4)));
typedef float f32x2 __attribute__((ext_vector_type(2)));
typedef float f32x4 __attribute__((ext_vector_type(4)));
typedef float f32x16 __attribute__((ext_vector_type(16)));
typedef unsigned u32x2 __attribute__((ext_vector_type(2)));
typedef unsigned u32x4 __attribute__((ext_vector_type(4)));
typedef int i32x4 __attribute__((ext_vector_type(4)));
typedef int i32x8 __attribute__((ext_vector_type(8)));

constexpr int DM = 2048, NBATCH = 4, SEQ = 4096, CTX = 256, RPB = SEQ + CTX, T = NBATCH * RPB, NH = 16, DEPTH = 2;
constexpr int IN_COLS = 6080, NP = 6144, NKV = 4096, NQ = 3072, NZ = 1024, NACT = 1536;
constexpr int P_Q = 512, P_KPE = 896, P_POOL = 1024, P_GM = 2048, P_GP = 4096;
constexpr int NPAIR = 24, NMOD = 6 * DM;
constexpr float EPS = 1e-6f;
constexpr int NWAVES = 8;

constexpr size_t MiB = 1u << 20;
constexpr size_t WS_CTL = 0, CTL_ZERO_BYTES = 1 * MiB;
constexpr size_t WS_LTOK = 4 * MiB, WS_LWA = 6 * MiB, WS_LWB = 8 * MiB;
constexpr size_t WS_MOD = 10 * MiB;
constexpr size_t WS_COS = 11 * MiB, WS_SIN = 12 * MiB;
constexpr size_t WS_W = 16 * MiB;
constexpr size_t LW_IN = 0, LW_IN8 = (size_t)2048 * DM * 2  , LW_KVB = LW_IN + (size_t)NP * DM * 2, LW_QB = LW_KVB + (size_t)NKV * 512 * 2, LW_POOL = LW_QB + (size_t)NQ * 384 * 2,
                 LW_OUT = LW_POOL + (size_t)4 * 512 * 256 * 2, LW_GU = LW_OUT + (size_t)DM * DM * 2, LW_D = LW_GU + (size_t)17 * 1024 * DM  ,
                 LW_BYTES = LW_D + (size_t)17 * DM * 512  ;
constexpr size_t WS_XCTX = 300 * MiB;
constexpr size_t WS_P = 308 * MiB;
constexpr size_t WS_Z = 512 * MiB;
constexpr size_t WS_KPE = 546 * MiB;
constexpr size_t WS_KV = 549 * MiB;
constexpr size_t WS_Q = 685 * MiB;
constexpr size_t WS_XB = WS_KV + 68 * MiB;
constexpr size_t WS_HM = 787 * MiB;
constexpr size_t WS_END = 855 * MiB;
static_assert(WS_W + 2 * LW_BYTES <= WS_XCTX, "weights fit");
static_assert(WS_XB + (size_t)T * DM * 2 <= WS_Q && (size_t)T * DM == 34 * MiB && (size_t)NBATCH * NH * 128 * RPB == 34 * MiB, "K8 | VT8 | XB fill the K/V region");
static_assert(WS_P + (size_t)T * NP * 2 <= WS_Z && WS_KV + (size_t)T * NKV * 2 <= WS_Q && WS_Q + (size_t)T * NQ * 2 <= WS_HM && WS_HM + (size_t)T * DM * 2 <= WS_END, "ws map");
constexpr int CW_BAR = 4096;
constexpr int CW_Q1 = 12288, CW_Q2 = 12352;
constexpr int CW_CNT = 16384;

constexpr int RING_BYTES = 131072;
constexpr int L_CIDX = RING_BYTES, L_CWA = L_CIDX + 8192, L_CWB = L_CWA + 8192, L_TAB = L_CWB + 8192, L_MISC = L_TAB + 512;
constexpr int LDS_BYTES = L_MISC + 512;
constexpr int MAXU = 8;
static_assert(MAXU * 256 == 4 * 512, "moe_setup: four cache entries per thread");

__device__ __forceinline__ unsigned cvt_pk(float lo, float hi) { unsigned r; asm("v_cvt_pk_bf16_f32 %0, %1, %2" : "=v"(r) : "v"(lo), "v"(hi)); return r; }
__device__ __forceinline__ float bf2f(unsigned h) { return __builtin_bit_cast(float, h << 16); }
__device__ __forceinline__ float bflo(unsigned w) { return __builtin_bit_cast(float, w << 16); }
__device__ __forceinline__ float bfhi(unsigned w) { return __builtin_bit_cast(float, w & 0xffff0000u); }
template <int CTRL> __device__ __forceinline__ float dppf(float v) { return __builtin_bit_cast(float, __builtin_amdgcn_update_dpp(0, __builtin_bit_cast(int, v), CTRL, 0xf, 0xf, true)); }
__device__ __forceinline__ float wave_sum(float v) {
    v += dppf<0xB1>(v);
    v += dppf<0x4E>(v);
    v += dppf<0x141>(v);
    v += dppf<0x140>(v);
    { auto rr = __builtin_amdgcn_permlane16_swap(__float_as_uint(v), __float_as_uint(v), false, false); v = __uint_as_float(rr[0]) + __uint_as_float(rr[1]); }
    { auto rr = __builtin_amdgcn_permlane32_swap(__float_as_uint(v), __float_as_uint(v), false, false); v = __uint_as_float(rr[0]) + __uint_as_float(rr[1]); }
    return v;
}
__device__ __forceinline__ float sigmoidf_(float x) { return __builtin_amdgcn_rcpf(1.f + __builtin_amdgcn_exp2f(-1.4426950408889634f * x)); }
__device__ __forceinline__ unsigned pk_fp8x4(float a, float b, float c, float d) {
    a = __builtin_amdgcn_fmed3f(a, -448.f, 448.f); b = __builtin_amdgcn_fmed3f(b, -448.f, 448.f); c = __builtin_amdgcn_fmed3f(c, -448.f, 448.f); d = __builtin_amdgcn_fmed3f(d, -448.f, 448.f);
    int w = 0; w = __builtin_amdgcn_cvt_pk_fp8_f32(a, b, w, false); w = __builtin_amdgcn_cvt_pk_fp8_f32(c, d, w, true); return (unsigned)w;
}
constexpr int SH_H2 = 2, SH_WGU = 6, SH_ACT = 3, SH_WD = 5, SH_H = 2, SH_WIN = 6, SH_Q = 3, SH_K = 3, SH_V = 3, SH_P = 4, SH_MIX = 3, SH_WOUT = 6, SH_LAT = 2, SH_WKQ = 5, SH_QC = 6;
constexpr float QK_C = 0.07216878364870322f * 1.4426950408889634f;
__device__ __forceinline__ int lane_now() { int l; asm volatile("v_mbcnt_lo_u32_b32 %0, -1, 0\n\tv_mbcnt_hi_u32_b32 %0, -1, %0" : "=v"(l)); return l; }
__device__ __forceinline__ int tid_from(int wave_s) { return wave_s * 64 + lane_now(); }
#define LDS_WAIT() asm volatile("s_waitcnt lgkmcnt(0)" ::: "memory")
#define VM_WAIT() asm volatile("s_waitcnt vmcnt(0)" ::: "memory")

#define XB_TMO      128
#define XB_XCNT(j)  (256  + 64 * (j))
#define XB_XSUB(j)  (1280 + 64 * (j))
#define XB_XGEN(j)  (2304 + 64 * (j))
#define XB_TOP      3328
#define XB_TOPGEN   3392
#define XCD_BAR_WORDS 3456
#define XB_SPIN_CAP (1u << 18)
__device__ __forceinline__ unsigned xb_ld(unsigned* p)              { return __hip_atomic_load(p, __ATOMIC_RELAXED, __HIP_MEMORY_SCOPE_AGENT); }
__device__ __forceinline__ unsigned xb_add(unsigned* p, unsigned v) { return __hip_atomic_fetch_add(p, v, __ATOMIC_RELAXED, __HIP_MEMORY_SCOPE_AGENT); }
__device__ __forceinline__ unsigned xb_xcc_id() { return (unsigned)__builtin_amdgcn_s_getreg((3 << 11) | 20) & 0xFu; }
#define XB_SPIN(cond, bar) do { unsigned _sp = 0; while (cond) { __builtin_amdgcn_s_sleep(1); \
    if ((++_sp & 255u) == 0u) { if (xb_ld(&(bar)[XB_TMO])) break; if (_sp > XB_SPIN_CAP) { atomicAdd(&(bar)[XB_TMO], 1u); break; } } } } while (0)
struct XcdBarrier { unsigned* bar; unsigned x; volatile LAS unsigned* st; };
__device__ __forceinline__ XcdBarrier xcd_barrier_post(unsigned* bar, volatile LAS unsigned* st, const bool leader) {
    XcdBarrier b; b.bar = bar; b.x = xb_xcc_id(); b.st = st;
    if (leader) (void)xb_add(&bar[XB_XCNT(b.x)], 1u);
    return b;
}
__device__ __forceinline__ void xcd_barrier_complete(unsigned* bar, unsigned x, unsigned& nloc, unsigned& nx) {
    const unsigned G = gridDim.x * gridDim.y * gridDim.z;
    unsigned sum, cnt, mine, sp = 0u;
    for (;;) {
        sum = 0u; cnt = 0u; mine = 0u;
#pragma unroll
        for (unsigned j = 0; j < 16; ++j) { const unsigned c = xb_ld(&bar[XB_XCNT(j)]); sum += c; cnt += (c > 0u) ? 1u : 0u; mine = (j == x) ? c : mine; }
        if (sum == G) break;
        __builtin_amdgcn_s_sleep(1);
        if ((++sp & 255u) == 0u) { if (xb_ld(&bar[XB_TMO])) break; if (sp > XB_SPIN_CAP) { atomicAdd(&bar[XB_TMO], 1u); break; } }
    }
    nloc = mine > 0u ? mine : 1u; nx = cnt > 0u ? cnt : 1u;
}
__device__ __forceinline__ void xcd_barrier(const XcdBarrier& b, const bool leader) {
    asm volatile("s_waitcnt vmcnt(0)" ::: "memory");
    __syncthreads();
    if (leader) {
        unsigned* bar = b.bar; const unsigned bx = b.x;
        __builtin_amdgcn_s_waitcnt(0);
        unsigned nloc = b.st[0], nx = b.st[1];
        if (nloc == 0u) { xcd_barrier_complete(bar, bx, nloc, nx); b.st[0] = nloc; b.st[1] = nx; }
        const unsigned old = xb_add(&bar[XB_XSUB(bx)], 1u);
        const unsigned gen = old / nloc;
        if (old + 1u == (gen + 1u) * nloc) {
            __builtin_amdgcn_fence(__ATOMIC_RELEASE, "agent");
            asm volatile("s_waitcnt vmcnt(0)" ::: "memory");
            const unsigned og = xb_add(&bar[XB_TOP], 1u);
            const unsigned tg = og / nx;
            if (og + 1u == (tg + 1u) * nx) xb_add(&bar[XB_TOPGEN], 1u);
            else XB_SPIN(xb_ld(&bar[XB_TOPGEN]) == tg, bar);
            __builtin_amdgcn_fence(__ATOMIC_ACQUIRE, "agent");
            xb_add(&bar[XB_XGEN(bx)], 1u);
            asm volatile("s_waitcnt vmcnt(0)" ::: "memory");
        } else {
            XB_SPIN(xb_ld(&bar[XB_XGEN(bx)]) == gen, bar);
            __builtin_amdgcn_fence(__ATOMIC_ACQUIRE, "agent");
            asm volatile("s_waitcnt vmcnt(0)" ::: "memory");
        }
    }
    __syncthreads();
}

struct Args { const float* in[25]; float* out; unsigned char* ws; int ph_lo, ph_hi; };
struct Frame {
    LAS unsigned char* lds;
    LAS unsigned char* ldsx;
    int tid, lane, wave, vcu, G, bx;
    const __attribute__((address_space(4))) Args* ap;
    __device__ __forceinline__ void fresh() { ap = (const __attribute__((address_space(4))) Args*)__builtin_amdgcn_kernarg_segment_ptr(); asm volatile("" : "+s"(ap));
        int t = tid_from(wave); asm volatile("" : "+v"(t)); tid = t; lane = t & 63;
        unsigned z = 0; asm volatile("" : "+s"(z)); ldsx = lds + z;
        int g = gridDim.x, b = blockIdx.x; asm volatile("" : "+s"(g), "+s"(b)); G = g; bx = b; vcu = (g % 8 == 0) ? (b % 8) * (g / 8) + b / 8 : b; }
    __device__ __forceinline__ const float* in(int i) const { return ap->in[i]; }
    __device__ __forceinline__ float* out() const { return ap->out; }
    __device__ __forceinline__ unsigned char* ws() const { return ap->ws; }
    __device__ __forceinline__ unsigned* ctl() const { return (unsigned*)(ap->ws + WS_CTL); }
    __device__ __forceinline__ float* xctx() const { return (float*)(ap->ws + WS_XCTX); }
    __device__ __forceinline__ bf16* P() const { return (bf16*)(ap->ws + WS_P); }
    __device__ __forceinline__ bf16* ACT() const { return (bf16*)(ap->ws + WS_P); }
    __device__ __forceinline__ bf16* Z() const { return (bf16*)(ap->ws + WS_Z); }
    __device__ __forceinline__ bf16* KPE() const { return (bf16*)(ap->ws + WS_KPE); }
    __device__ __forceinline__ bf16* KV() const { return (bf16*)(ap->ws + WS_KV); }
    __device__ __forceinline__ bf16* Q() const { return (bf16*)(ap->ws + WS_Q); }
    __device__ __forceinline__ bf16* HM() const { return (bf16*)(ap->ws + WS_HM); }
    __device__ __forceinline__ unsigned char* K8() const { return ap->ws + WS_KV; }
    __device__ __forceinline__ unsigned char* VT8() const { return ap->ws + WS_KV + 34 * MiB; }
    __device__ __forceinline__ unsigned char* Q8() const { return ap->ws + WS_Q; }
    __device__ __forceinline__ unsigned char* KPE8() const { return ap->ws + WS_KPE; }
    __device__ __forceinline__ unsigned char* M8() const { return ap->ws + WS_Z; }
    __device__ __forceinline__ bf16* XB() const { return (bf16*)(ap->ws + WS_XB); }
    __device__ __forceinline__ float* mod() const { return (float*)(ap->ws + WS_MOD); }
    __device__ __forceinline__ float* cosT() const { return (float*)(ap->ws + WS_COS); }
    __device__ __forceinline__ float* sinT() const { return (float*)(ap->ws + WS_SIN); }
    __device__ __forceinline__ int* ltok() const { return (int*)(ap->ws + WS_LTOK); }
    __device__ __forceinline__ float* lwa() const { return (float*)(ap->ws + WS_LWA); }
    __device__ __forceinline__ float* lwb() const { return (float*)(ap->ws + WS_LWB); }
};
__device__ __forceinline__ const float* xin_row(const Frame& F, int r) { const int b = r / RPB, j = r - b * RPB; return j < CTX ? F.in(2) + (size_t)(b * CTX + j) * DM : F.in(0) + (size_t)(b * SEQ + j - CTX) * DM; }
__device__ __forceinline__ bf16* xres_row(const Frame& F, int r) { return F.XB() + (size_t)r * DM; }
__device__ __forceinline__ f32x4 ld4bf(const bf16* p) { const u32x2 w = *(const u32x2*)p; return (f32x4){bflo(w.x), bfhi(w.x), bflo(w.y), bfhi(w.y)}; }
__device__ __forceinline__ int mod_row(int r) { const int b = r / RPB, j = r - b * RPB; return j < CTX ? 4 : b; }

namespace pg8 {
constexpr int BM = 256, BK = 64, HALF = 128, HTB = HALF * BK * 2, NXCD = 8, WGM = 8;
__device__ __forceinline__ int lds_byte(int r, int c) { const int st = (r >> 4) * 2 + (c >> 5), rr = r & 15, cc = c & 31, ob = rr * 64 + cc * 2; return st * 1024 + (ob ^ (((ob >> 9) & 1) << 5)); }
__device__ __forceinline__ void stage_rc(int b, int& R, int& C) { const int st = b / 1024, sb = b % 1024, swz = sb ^ (((sb >> 9) & 1) << 5); R = (st >> 1) * 16 + swz / 64; C = (st & 1) * 32 + (swz % 64) / 2; }
__device__ __forceinline__ int perm32(int rho) { const int n = rho >> 4, i = rho & 15; return 8 * (i >> 2) + 4 * n + (i & 3); }

struct Unit { int pm, pn, p, nrows, slot, arow0, ea, eb, kind; };

__device__ __forceinline__ void static_map(int L, int nM, int nN, int& pm, int& pn) {
    const int nwg = nM * nN; int wgid = L; { const int q = nwg / NXCD, r = nwg % NXCD, xcd = wgid % NXCD, off = wgid / NXCD; wgid = (xcd < r ? xcd * (q + 1) : r * (q + 1) + (xcd - r) * q) + off; }
    const int nig = WGM * nN, gid = wgid / nig, fm = gid * WGM, gsz = (nM - fm) < WGM ? (nM - fm) : WGM;
    pm = fm + ((wgid % nig) % gsz); pn = (wgid % nig) / gsz;
}
__device__ __forceinline__ bool static_next(int i, int G, int c, int nM, int nN, int& pm, int& pn) {
    const int nwg = nM * nN; const long L = (long)i * G + c; if (L >= nwg) return false;
    int wgid = (int)L; { const int q = nwg / NXCD, r = nwg % NXCD, xcd = wgid % NXCD, off = wgid / NXCD; wgid = (xcd < r ? xcd * (q + 1) : r * (q + 1) + (xcd - r) * q) + off; }
    const int nig = WGM * nN, gid = wgid / nig, fm = gid * WGM, gsz = (nM - fm) < WGM ? (nM - fm) : WGM;
    pm = fm + ((wgid % nig) % gsz); pn = (wgid % nig) / gsz; return true;
}
struct DenseSched {
    const bf16* A; const bf16* Bt; int lda, ldb, nM, nN, G, c, a_shift, a_stride; bool lat_only;
    int K; int pn_off;
    __device__ __forceinline__ bool next(int i, Unit& u) const { u.p = 0; u.nrows = 256; u.slot = 0; u.arow0 = 0; u.ea = 0; u.eb = 0; u.kind = 0; const bool ok = static_next(i, G, c, nM, nN, u.pm, u.pn);
        if (lat_only) u.pm += (u.pm >> 4) + 1; u.pn += pn_off; return ok; }
    static constexpr bool FP8 = false, MIXED = false;
    __device__ __forceinline__ int scale_a() const { return 127; }
    __device__ __forceinline__ int scale_b() const { return 127; }
    __device__ __forceinline__ int nt(const Unit&) const { return K / BK; }
    __device__ __forceinline__ int ldbv(const Unit&) const { return ldb; }
    __device__ __forceinline__ const char* a_base(const Unit& u) const { return (const char*)(A + (size_t)((u.pn >> a_shift) * a_stride)); }
    __device__ __forceinline__ unsigned a_off(const Unit& u, int row, int col) const { return (unsigned)(((u.pm * 256 + row) * lda + col) * 2); }
    __device__ __forceinline__ const char* b_tile(const Unit& u, int t) const { return (const char*)(Bt + (size_t)u.pn * 256 * ldb + (size_t)t * BK); }
};
struct TriSched {
    const unsigned char* ws; size_t wl; int G, c, nMq; bool lat_only;
    __device__ __forceinline__ bool next(int i, Unit& u) const { u.p = 0; u.nrows = 256; u.slot = 0; u.arow0 = 0; u.ea = 0; u.eb = 0;
        int L = i * G + c; const int n0 = (T / 256) * 16, n1 = nMq * 12, n2 = nMq * 8;
        if (L < n0) { u.kind = 0; static_map(L, T / 256, 16, u.pm, u.pn); return true; } L -= n0;
        if (L < n1) { u.kind = 1; static_map(L, nMq, 12, u.pm, u.pn); if (lat_only) u.pm += (u.pm >> 4) + 1; return true; } L -= n1;
        if (L < n2) { u.kind = 2; static_map(L, nMq, 8, u.pm, u.pn); if (lat_only) u.pm += (u.pm >> 4) + 1; return true; }
        return false; }
    static constexpr bool FP8 = false, MIXED = false;
    __device__ __forceinline__ int scale_a() const { return 127; }
    __device__ __forceinline__ int scale_b() const { return 127; }
    __device__ __forceinline__ int nt(const Unit& u) const { return u.kind == 0 ? 8 : (u.kind == 1 ? 6 : 4); }
    __device__ __forceinline__ int ldbv(const Unit& u) const { return u.kind == 0 ? 512 : (u.kind == 1 ? 384 : 256); }
    __device__ __forceinline__ const char* a_base(const Unit& u) const { const size_t off = u.kind == 0 ? WS_P : (u.kind == 1 ? WS_P + (size_t)P_Q * 2 : WS_Z + (size_t)(u.pn >> 1) * 512); return (const char*)(ws + off); }
    __device__ __forceinline__ unsigned a_off(const Unit& u, int row, int col) const { return (unsigned)(((u.pm * 256 + row) * (u.kind == 2 ? NZ : NP) + col) * 2); }
    __device__ __forceinline__ const char* b_tile(const Unit& u, int t) const { const size_t off = u.kind == 0 ? LW_KVB : (u.kind == 1 ? LW_QB : LW_POOL);
        return (const char*)(ws + wl + off + ((size_t)u.pn * 256 * ldbv(u) + (size_t)t * BK) * 2); }
};
struct A8Sched {
    const unsigned char* A; const unsigned char* W8; int G, c;
    static constexpr bool FP8 = true, MIXED = false;
    __device__ __forceinline__ int scale_a() const { return 127 - SH_H; }
    __device__ __forceinline__ int scale_b() const { return 127 - SH_WIN; }
    __device__ __forceinline__ bool next(int i, Unit& u) const { u.p = 0; u.nrows = 256; u.slot = 0; u.arow0 = 0; u.ea = 0; u.eb = 0; u.kind = 0;
        return static_next(i, G, c, T / 256, 24, u.pm, u.pn); }
    __device__ __forceinline__ int nt(const Unit&) const { return DM / 128; }
    __device__ __forceinline__ int ldbv(const Unit&) const { return DM / 2; }
    __device__ __forceinline__ const char* a_base(const Unit&) const { return (const char*)A; }
    __device__ __forceinline__ unsigned a_off(const Unit& u, int row, int col) const { return (unsigned)((u.pm * 256 + row) * DM + col * 2); }
    __device__ __forceinline__ const char* b_tile(const Unit& u, int t) const { return (const char*)(W8 + (size_t)u.pn * 256 * DM + (size_t)t * 128); }
};
struct D8Sched {
    const unsigned char* A; const unsigned char* W8; int G, c, nM; bool lat_only;
    static constexpr bool FP8 = true, MIXED = false;
    __device__ __forceinline__ int scale_a() const { return 127 - SH_MIX; }
    __device__ __forceinline__ int scale_b() const { return 127 - SH_WOUT; }
    __device__ __forceinline__ bool next(int i, Unit& u) const { u.p = 0; u.nrows = 256; u.slot = 0; u.arow0 = 0; u.ea = 0; u.eb = 0; u.kind = 0;
        const bool ok = static_next(i, G, c, nM, 8, u.pm, u.pn); if (lat_only) u.pm += (u.pm >> 4) + 1; return ok; }
    __device__ __forceinline__ int nt(const Unit&) const { return DM / 128; }
    __device__ __forceinline__ int ldbv(const Unit&) const { return DM / 2; }
    __device__ __forceinline__ const char* a_base(const Unit&) const { return (const char*)A; }
    __device__ __forceinline__ unsigned a_off(const Unit& u, int row, int col) const { return (unsigned)((u.pm * 256 + row) * DM + col * 2); }
    __device__ __forceinline__ const char* b_tile(const Unit& u, int t) const { return (const char*)(W8 + (size_t)u.pn * 256 * DM + (size_t)t * 128); }
};
struct KQ8Sched {
    const unsigned char* ws; size_t wl; int G, c, nMq; bool lat_only;
    static constexpr bool FP8 = true, MIXED = false;
    __device__ __forceinline__ int scale_a() const { return 127 - SH_LAT; }
    __device__ __forceinline__ int scale_b() const { return 127 - SH_WKQ; }
    __device__ __forceinline__ bool next(int i, Unit& u) const { u.p = 0; u.nrows = 256; u.slot = 0; u.arow0 = 0; u.ea = 0; u.eb = 0;
        int L = i * G + c; const int n0 = (T / 256) * 16, n1 = nMq * 12;
        if (L < n0) { u.kind = 0; static_map(L, T / 256, 16, u.pm, u.pn); return true; } L -= n0;
        if (L < n1) { u.kind = 1; static_map(L, nMq, 12, u.pm, u.pn); if (lat_only) u.pm += (u.pm >> 4) + 1; return true; }
        return false; }
    __device__ __forceinline__ int nt(const Unit&) const { return 4; }
    __device__ __forceinline__ int ldbv(const Unit&) const { return 256; }
    __device__ __forceinline__ const char* a_base(const Unit& u) const { return (const char*)(ws + WS_P + (u.kind == 0 ? 0 : (size_t)P_Q * 2)); }
    __device__ __forceinline__ unsigned a_off(const Unit& u, int row, int col) const { return (unsigned)((u.pm * 256 + row) * (NP * 2) + col * 2); }
    __device__ __forceinline__ const char* b_tile(const Unit& u, int t) const { return (const char*)(ws + wl + (u.kind == 0 ? LW_KVB : LW_QB) + (size_t)u.pn * 256 * 512 + (size_t)t * 128); }
};
__device__ __forceinline__ bool moe_next(int i, int G, int c, int nN, const volatile LAS int* tab, Unit& u) {
    const int total = tab[24 + NPAIR]; const int L = i * G + c; if (L >= total * nN) return false;
    const int mt = L / nN; u.pn = L - mt * nN; int p = 0;
#pragma unroll 1
    for (int q = 1; q < NPAIR; ++q) if (tab[24 + q] <= mt) p = q;
    u.p = p; u.pm = mt - tab[24 + p]; const int rem = tab[p] - u.pm * 256; u.nrows = rem < 256 ? rem : 256; u.slot = i; u.arow0 = mt * 256;
    const int g = p / 6, x = p - g * 6; const int a = x < 3 ? 0 : (x < 5 ? 1 : 2), b = x < 3 ? x + 1 : (x < 5 ? x - 1 : 3);
    u.ea = 4 * g + a; u.eb = 4 * g + b; u.kind = 0; return true;
}
struct MoeUpSched {
    const unsigned char* A; const unsigned char* Wgu; int G, c; const volatile LAS int* tab; const volatile LAS int* cidx;
    static constexpr bool FP8 = true, MIXED = false;
    __device__ __forceinline__ int scale_a() const { return 127 - SH_H2; }
    __device__ __forceinline__ int scale_b() const { return 127 - SH_WGU; }
    __device__ __forceinline__ bool next(int i, Unit& u) const { return moe_next(i, G, c, 12, tab, u); }
    __device__ __forceinline__ int nt(const Unit&) const { return DM / 128; }
    __device__ __forceinline__ int ldbv(const Unit&) const { return DM / 2; }
    __device__ __forceinline__ const char* a_base(const Unit&) const { return (const char*)A; }
    __device__ __forceinline__ unsigned a_off(const Unit& u, int row, int col) const { return (unsigned)(cidx[u.slot * 256 + row] * DM + col * 2); }
    __device__ __forceinline__ const char* b_tile(const Unit& u, int t) const { const int seg = u.pn >> 2, e = seg == 0 ? 16 : (seg == 1 ? u.ea : u.eb);
        return (const char*)(Wgu + ((size_t)e * 1024 + (size_t)(u.pn & 3) * 256) * DM + (size_t)t * 128); }
};
struct MoeDownSched {
    const unsigned char* A; const unsigned char* Wd; int G, c; const volatile LAS int* tab;
    static constexpr bool FP8 = true, MIXED = false;
    __device__ __forceinline__ int scale_a() const { return 127 - SH_ACT; }
    __device__ __forceinline__ int scale_b() const { return 127 - SH_WD; }
    __device__ __forceinline__ bool next(int i, Unit& u) const { return moe_next(i, G, c, 8, tab, u); }
    __device__ __forceinline__ int nt(const Unit&) const { return NACT / 128; }
    __device__ __forceinline__ int ldbv(const Unit&) const { return 512 / 2; }
    __device__ __forceinline__ const char* a_base(const Unit&) const { return (const char*)A; }
    __device__ __forceinline__ unsigned a_off(const Unit& u, int row, int col) const { return (unsigned)((u.arow0 + row) * NACT + col * 2); }
    __device__ __forceinline__ const char* b_tile(const Unit& u, int t) const { const int seg = t >> 2, e = ((16 | (u.ea << 8) | (u.eb << 16)) >> (8 * seg)) & 0xff;
        return (const char*)(Wd + ((size_t)e * DM + (size_t)u.pn * 256) * 512 + (size_t)(t & 3) * 128); }
};

template <class Epi, class Sched, bool ALIGN_EPI>
__device__ __forceinline__ void gemm_phase(LAS unsigned char* lds, const int wave, const Sched& S, const Epi& E) {
    int tid = tid_from(wave); asm volatile("" : "+v"(tid));
    const int wid = wave, lane = tid & 63, wr = wid >> 2, wc = wid & 3, fr = lane & 15, fq = lane >> 4;
    unsigned voffB[2];
    const size_t kstep = (size_t)(BK * 2);
    size_t hstepB;
#define PG8_BOFF(u) do { int _t = tid; asm volatile("" : "+v"(_t)); const int _ldb = S.ldbv(u); hstepB = (size_t)HALF * _ldb * 2; _Pragma("unroll") for (int _i = 0; _i < 2; ++_i) { int R, C; stage_rc(_t * 16 + _i * 8192, R, C); \
        const int Rb = (R & ~31) + perm32(R & 31); voffB[_i] = (unsigned)(Rb * _ldb + C) * 2u; } } while (0)
    const unsigned ldsw = (unsigned)wid * 1024u;
    constexpr bool FP8 = Sched::FP8;
    constexpr bool MIXED = Sched::MIXED;
    bool f8 = FP8;
    int aoff = FP8 ? lds_byte(wr * 64 + fr, (fq >> 1) * 32 + (fq & 1) * 8) : lds_byte(wr * 64 + fr, fq * 8), boff = FP8 ? lds_byte(wc * 32 + fr, (fq >> 1) * 32 + (fq & 1) * 8) : lds_byte(wc * 32 + fr, fq * 8);
    int aoffH = FP8 ? (aoff ^ 32) : aoff + 1024, boffH = FP8 ? (boff ^ 32) : boff + 1024;
#define PG8_FRAG(u) do { if constexpr (MIXED) { f8 = S.unit_f8(u); int _l = tid; asm volatile("" : "+v"(_l)); const int _fr = _l & 15, _fq = (_l & 63) >> 4; \
        aoff = lds_byte(wr * 64 + _fr, _fq * (f8 ? 16 : 8)); boff = lds_byte(wc * 32 + _fr, _fq * (f8 ? 16 : 8)); aoffH = aoff + (f8 ? 16 : 1024); boffH = boff + (f8 ? 16 : 1024); } } while (0)
    const int scA = S.scale_a() * 0x01010101, scB = S.scale_b() * 0x01010101;
#define PG8_SA(b, h) (((b) * 2 + (h)) * HTB)
#define PG8_SB(b, h) ((4 + (b) * 2 + (h)) * HTB)
#define PG8_STAGE(bufoff, gbase, voff) do { _Pragma("unroll") for (int _i = 0; _i < 2; ++_i) \
        __builtin_amdgcn_global_load_lds((const unsigned*)((const char*)(gbase) + (voff)[_i]), (LAS unsigned*)(lds + (bufoff) + ldsw + _i * 8192), 16, 0, 0); } while (0)
#define PG8_CAT(lo, hi) __builtin_shufflevector(lo, hi, 0, 1, 2, 3, 4, 5, 6, 7)
#define PG8_LO(x) __builtin_bit_cast(bf16x8, __builtin_shufflevector(x, x, 0, 1, 2, 3))
#define PG8_HI(x) __builtin_bit_cast(bf16x8, __builtin_shufflevector(x, x, 4, 5, 6, 7))
#define PG8_LDA(dst, b, h) do { _Pragma("unroll") for (int m = 0; m < 4; ++m) { \
        if constexpr (MIXED) { const i32x4 _lo = *(const LAS i32x4*)(lds + PG8_SA(b, h) + aoff + m * 2048), _hi = *(const LAS i32x4*)(lds + PG8_SA(b, h) + aoffH + m * 2048); dst##8[m] = PG8_CAT(_lo, _hi); } \
        else if constexpr (FP8) { const i32x4 _lo = *(const LAS i32x4*)(lds + PG8_SA(b, h) + aoff + m * 2048), _hi = *(const LAS i32x4*)(lds + PG8_SA(b, h) + aoffH + m * 2048); dst##8[m] = PG8_CAT(_lo, _hi); } \
        else { _Pragma("unroll") for (int k = 0; k < 2; ++k) dst[m][k] = *(const LAS bf16x8*)(lds + PG8_SA(b, h) + aoff + m * 2048 + k * 1024); } } } while (0)
#define PG8_LDB(dst, b, h) do { _Pragma("unroll") for (int n = 0; n < 2; ++n) { \
        if constexpr (MIXED) { const i32x4 _lo = *(const LAS i32x4*)(lds + PG8_SB(b, h) + boff + n * 2048), _hi = *(const LAS i32x4*)(lds + PG8_SB(b, h) + boffH + n * 2048); dst##8[n] = PG8_CAT(_lo, _hi); } \
        else if constexpr (FP8) { const i32x4 _lo = *(const LAS i32x4*)(lds + PG8_SB(b, h) + boff + n * 2048), _hi = *(const LAS i32x4*)(lds + PG8_SB(b, h) + boffH + n * 2048); dst##8[n] = PG8_CAT(_lo, _hi); } \
        else { _Pragma("unroll") for (int k = 0; k < 2; ++k) dst[n][k] = *(const LAS bf16x8*)(lds + PG8_SB(b, h) + boff + n * 2048 + k * 1024); } } } while (0)
#define PG8_MMA(ai, bj, At, Bt) do { __builtin_amdgcn_s_setprio(1); \
        if constexpr (MIXED) { if (f8) { _Pragma("unroll") for (int m = 0; m < 4; ++m) _Pragma("unroll") for (int n = 0; n < 2; ++n) \
                acc[ai][bj][m][n] = __builtin_amdgcn_mfma_scale_f32_16x16x128_f8f6f4(Bt##8[n], At##8[m], acc[ai][bj][m][n], 0, 0, 0, scB, 0, scA); } \
            else { _Pragma("unroll") for (int m = 0; m < 4; ++m) _Pragma("unroll") for (int n = 0; n < 2; ++n) { \
                acc[ai][bj][m][n] = __builtin_amdgcn_mfma_f32_16x16x32_bf16(PG8_LO(Bt##8[n]), PG8_LO(At##8[m]), acc[ai][bj][m][n], 0, 0, 0); \
                acc[ai][bj][m][n] = __builtin_amdgcn_mfma_f32_16x16x32_bf16(PG8_HI(Bt##8[n]), PG8_HI(At##8[m]), acc[ai][bj][m][n], 0, 0, 0); } } } \
        else { _Pragma("unroll") for (int m = 0; m < 4; ++m) _Pragma("unroll") for (int n = 0; n < 2; ++n) { \
        if constexpr (FP8) acc[ai][bj][m][n] = __builtin_amdgcn_mfma_scale_f32_16x16x128_f8f6f4(Bt##8[n], At##8[m], acc[ai][bj][m][n], 0, 0, 0, scB, 0, scA); \
        else { _Pragma("unroll") for (int k = 0; k < 2; ++k) acc[ai][bj][m][n] = __builtin_amdgcn_mfma_f32_16x16x32_bf16(Bt[n][k], At[m][k], acc[ai][bj][m][n], 0, 0, 0); } } } \
        __builtin_amdgcn_s_setprio(0); } while (0)
#define PG8_WAIT_V(n) asm volatile("s_waitcnt vmcnt(" #n ")" ::: "memory")
#define PG8_WAIT_L(n) asm volatile("s_waitcnt lgkmcnt(" #n ")" ::: "memory")
#define PG8_BAR __builtin_amdgcn_s_barrier()
#define PG8_SCHED __builtin_amdgcn_sched_barrier(0)
#define PG8_AOFF(u) do { int _t = tid; asm volatile("" : "+v"(_t)); _Pragma("unroll") for (int _i = 0; _i < 2; ++_i) { int R, C; stage_rc(_t * 16 + _i * 8192, R, C); \
        oA0[_i] = S.a_off(u, R, C); oA1[_i] = S.a_off(u, HALF + R, C); } } while (0)
    Unit cur, nxt; int ui = 0;
    if (!S.next(0, cur)) return;
    f32x4 acc[2][2][4][2];
    float zf = 0.f; asm volatile("" : "+v"(zf));
#pragma unroll
    for (int a = 0; a < 2; ++a)
#pragma unroll
        for (int b = 0; b < 2; ++b)
#pragma unroll
            for (int m = 0; m < 4; ++m)
#pragma unroll
                for (int n = 0; n < 2; ++n) acc[a][b][m][n] = (f32x4){zf, zf, zf, zf};
    bf16x8 At[4][2], B0[2][2], B1[2][2]; i32x8 At8[4], B08[2], B18[2];
    unsigned oA0[2], oA1[2];
    PG8_AOFF(cur); PG8_BOFF(cur); PG8_FRAG(cur);
    int nt = S.nt(cur); asm volatile("" : "+s"(nt));
    const char* cA = S.a_base(cur);
    {
        const char* b0 = S.b_tile(cur, 0); const char* b1 = S.b_tile(cur, 1);
        PG8_STAGE(PG8_SB(0, 0), b0, voffB); PG8_STAGE(PG8_SB(0, 1), b0 + hstepB, voffB); PG8_STAGE(PG8_SA(0, 0), cA, oA0); PG8_STAGE(PG8_SA(0, 1), cA, oA1);
        if (wr == 1) PG8_BAR;
        PG8_WAIT_V(2); PG8_BAR;
        PG8_STAGE(PG8_SB(1, 0), b1, voffB); PG8_STAGE(PG8_SA(1, 0), cA + kstep, oA0); PG8_STAGE(PG8_SB(1, 1), b1 + hstepB, voffB);
        PG8_WAIT_V(6); PG8_BAR;
    }
    for (;;) {
        const bool has_next = S.next(ui + 1, nxt);
        for (int t = 0; t < nt; t += 2) {
            const bool last = (t == nt - 2);
            const bool sw = last && has_next;
            PG8_LDB(B0, 0, 0); PG8_LDB(B1, 0, 1); PG8_SCHED; PG8_LDA(At, 0, 0); PG8_STAGE(PG8_SA(1, 1), cA + (size_t)(t + 1) * kstep, oA1);
            if (sw) { PG8_AOFF(nxt); PG8_BOFF(nxt); cA = S.a_base(nxt); }
            const char* a2 = last ? cA : cA + (size_t)(t + 2) * kstep;
            const char* b2 = last ? (has_next ? S.b_tile(nxt, 0) : S.b_tile(cur, 0)) : S.b_tile(cur, t + 2);
            const char* b3 = last ? (has_next ? S.b_tile(nxt, 1) : S.b_tile(cur, 1)) : S.b_tile(cur, t + 3);
            PG8_WAIT_V(8); PG8_WAIT_L(0); PG8_BAR; PG8_MMA(0, 0, At, B0); PG8_MMA(0, 1, At, B1); PG8_BAR; PG8_SCHED;
            PG8_LDA(At, 0, 1); PG8_STAGE(PG8_SB(0, 0), b2, voffB); PG8_STAGE(PG8_SB(0, 1), b2 + hstepB, voffB); PG8_STAGE(PG8_SA(0, 0), a2, oA0);
            PG8_WAIT_V(8); PG8_WAIT_L(0); PG8_BAR; PG8_MMA(1, 0, At, B0); PG8_MMA(1, 1, At, B1); PG8_BAR; PG8_SCHED;
            PG8_LDB(B0, 1, 0); PG8_LDB(B1, 1, 1); PG8_SCHED; PG8_LDA(At, 1, 0); PG8_STAGE(PG8_SA(0, 1), a2, oA1);
            PG8_WAIT_V(8); PG8_WAIT_L(0); PG8_BAR; PG8_MMA(0, 0, At, B0); PG8_MMA(0, 1, At, B1); PG8_BAR; PG8_SCHED;
            PG8_LDA(At, 1, 1); PG8_STAGE(PG8_SB(1, 0), b3, voffB); PG8_STAGE(PG8_SB(1, 1), b3 + hstepB, voffB); PG8_STAGE(PG8_SA(1, 0), a2 + kstep, oA0);
            PG8_WAIT_V(8); PG8_WAIT_L(0); PG8_BAR; PG8_MMA(1, 0, At, B0); PG8_MMA(1, 1, At, B1); PG8_BAR; PG8_SCHED;
        }
        if constexpr (ALIGN_EPI) { if (wr == 0) PG8_BAR; }
        E(acc, cur, wr, wc, fr, fq);
        if (!has_next) break;
        asm volatile("" : "+v"(zf));
#pragma unroll
        for (int a = 0; a < 2; ++a)
#pragma unroll
            for (int b = 0; b < 2; ++b)
#pragma unroll
                for (int m = 0; m < 4; ++m)
#pragma unroll
                    for (int n = 0; n < 2; ++n) acc[a][b][m][n] = (f32x4){zf, zf, zf, zf};
        cur = nxt; ++ui; nt = S.nt(cur); asm volatile("" : "+s"(nt)); PG8_FRAG(cur);
        if constexpr (ALIGN_EPI) { if (wr == 1) PG8_BAR; }
    }
    PG8_WAIT_V(0);
    if constexpr (!ALIGN_EPI) { if (wr == 0) PG8_BAR; }
    PG8_BAR;
#undef PG8_AOFF
#undef PG8_BOFF
#undef PG8_SA
#undef PG8_SB
#undef PG8_STAGE
#undef PG8_LDA
#undef PG8_LDB
#undef PG8_MMA
#undef PG8_CAT
#undef PG8_LO
#undef PG8_HI
#undef PG8_FRAG
#undef PG8_WAIT_V
#undef PG8_WAIT_L
#undef PG8_BAR
#undef PG8_SCHED
}

typedef f32x4 Acc[2][2][4][2];
__device__ __forceinline__ u32x4 pack8(f32x4 v0, f32x4 v1) { u32x4 w; w.x = cvt_pk(v0[0], v0[1]); w.y = cvt_pk(v0[2], v0[3]); w.z = cvt_pk(v1[0], v1[1]); w.w = cvt_pk(v1[2], v1[3]); return w; }
__device__ __forceinline__ void unpack8(u32x4 w, f32x4& v0, f32x4& v1) { v0 = (f32x4){bflo(w.x), bfhi(w.x), bflo(w.y), bfhi(w.y)}; v1 = (f32x4){bflo(w.z), bfhi(w.z), bflo(w.w), bfhi(w.w)}; }

struct EpiP {
    bf16* O;
    __device__ __forceinline__ void operator()(const Acc& acc, const Unit& u, int wr, int wc, int fr, int fq) const {
        asm volatile("" : "+v"(fr), "+v"(fq));
        const int row0 = u.pm * BM + wr * 64 + fr, col0 = u.pn * BM + wc * 32 + 8 * fq; const bool sg = u.pn >= 8;
#pragma unroll
        for (int ai = 0; ai < 2; ++ai)
#pragma unroll
            for (int m = 0; m < 4; ++m) { bf16* rowp = O + (size_t)(row0 + ai * HALF + m * 16) * NP + col0;
#pragma unroll
                for (int bj = 0; bj < 2; ++bj) { f32x4 v0 = acc[ai][bj][m][0], v1 = acc[ai][bj][m][1];
                    if (sg) {
#pragma unroll
                        for (int j = 0; j < 4; ++j) { v0[j] = sigmoidf_(v0[j]); v1[j] = sigmoidf_(v1[j]); } }
                    *(u32x4*)(rowp + bj * HALF) = pack8(v0, v1); } }
    }
};
struct EpiStore {
    bf16* O; int ldc;
    __device__ __forceinline__ void operator()(const Acc& acc, const Unit& u, int wr, int wc, int fr, int fq) const {
        asm volatile("" : "+v"(fr), "+v"(fq));
        const int row0 = u.pm * BM + wr * 64 + fr, col0 = u.pn * BM + wc * 32 + 8 * fq;
#pragma unroll
        for (int ai = 0; ai < 2; ++ai)
#pragma unroll
            for (int m = 0; m < 4; ++m) { bf16* rowp = O + (size_t)(row0 + ai * HALF + m * 16) * ldc + col0;
#pragma unroll
                for (int bj = 0; bj < 2; ++bj) *(u32x4*)(rowp + bj * HALF) = pack8(acc[ai][bj][m][0], acc[ai][bj][m][1]); }
    }
};
struct EpiQ {
    bf16* O; const float* cosT; const float* sinT;
    __device__ __forceinline__ void operator()(const Acc& acc, const Unit& u, int wr, int wc, int fr, int fq) const {
        asm volatile("" : "+v"(fr), "+v"(fq));
        const int row0 = u.pm * BM + wr * 64 + fr, col0 = u.pn * BM + wc * 32 + 8 * fq;
        const int jt = u.pm % 17; const bool lat = jt != 0; const int pos0 = (jt - 1) * 256 + wr * 64 + fr;
#pragma unroll
        for (int bj = 0; bj < 2; ++bj) { const int c = col0 + bj * HALF, d = c % 192; const bool pe = lat && d >= 128; const int i0 = (d - 128) >> 1;
#pragma unroll
            for (int ai = 0; ai < 2; ++ai)
#pragma unroll
                for (int m = 0; m < 4; ++m) { f32x4 v0 = acc[ai][bj][m][0], v1 = acc[ai][bj][m][1];
                    if (pe) { const int pos = pos0 + ai * HALF + m * 16; const f32x4 cs = *(const f32x4*)(cosT + pos * 32 + i0), sn = *(const f32x4*)(sinT + pos * 32 + i0);
                        f32x4 r0, r1;
                        r0[0] = v0[0] * cs[0] - v0[1] * sn[0]; r0[1] = v0[1] * cs[0] + v0[0] * sn[0]; r0[2] = v0[2] * cs[1] - v0[3] * sn[1]; r0[3] = v0[3] * cs[1] + v0[2] * sn[1];
                        r1[0] = v1[0] * cs[2] - v1[1] * sn[2]; r1[1] = v1[1] * cs[2] + v1[0] * sn[2]; r1[2] = v1[2] * cs[3] - v1[3] * sn[3]; r1[3] = v1[3] * cs[3] + v1[2] * sn[3];
                        v0 = r0; v1 = r1; }
                    *(u32x4*)(O + (size_t)(row0 + ai * HALF + m * 16) * NQ + c) = pack8(v0, v1); } }
    }
};
template <int K> __device__ __forceinline__ unsigned quad_bcast(unsigned x) { return (unsigned)__builtin_amdgcn_update_dpp(0, (int)x, K * 0x55, 0xf, 0xf, true); }
__device__ __forceinline__ unsigned quad_tr(unsigned w, unsigned sel) {
    const unsigned x0 = quad_bcast<0>(w), x1 = quad_bcast<1>(w), x2 = quad_bcast<2>(w), x3 = quad_bcast<3>(w);
    const unsigned lo = __builtin_amdgcn_perm(x1, x0, sel), hi = __builtin_amdgcn_perm(x3, x2, sel);
    return __builtin_amdgcn_perm(hi, lo, 0x05040100u);
}
struct EpiKV8 {
    unsigned char* K8; unsigned char* VT8;
    __device__ __forceinline__ void operator()(const Acc& acc, const Unit& u, int wr, int wc, int fr, int fq) const {
        asm volatile("" : "+v"(fr), "+v"(fq));
        const int row0 = u.pm * BM + wr * 64 + fr, b = u.pm / 17, jt = u.pm - b * 17; constexpr float SK = (float)(1 << SH_K), SV = (float)(1 << SH_V);
#pragma unroll
        for (int ai = 0; ai < 2; ++ai)
#pragma unroll
            for (int m = 0; m < 4; ++m) { const int r = row0 + ai * HALF + m * 16;
                { const f32x4 v0 = acc[ai][0][m][0] * SK, v1 = acc[ai][0][m][1] * SK; u32x2 o; o.x = pk_fp8x4(v0[0], v0[1], v0[2], v0[3]); o.y = pk_fp8x4(v1[0], v1[1], v1[2], v1[3]);
                  *(u32x2*)(K8 + (size_t)r * DM + u.pn * 128 + wc * 32 + 8 * fq) = o; }
                { const f32x4 v0 = acc[ai][1][m][0] * SV, v1 = acc[ai][1][m][1] * SV; const unsigned w0 = pk_fp8x4(v0[0], v0[1], v0[2], v0[3]), w1 = pk_fp8x4(v1[0], v1[1], v1[2], v1[3]);
                  const int qi = fr & 3; const unsigned sel = (unsigned)qi | ((unsigned)(4 + qi) << 8);
                  const unsigned t0 = quad_tr(w0, sel), t1 = quad_tr(w1, sel);
                  const int tile = jt * 4 + ai * 2 + wr, slot0 = 32 * ((fr >> 2) & 1) + 16 * (m >> 1) + 4 * (2 * (m & 1) + (fr >> 3));
                  unsigned char* vp = VT8 + ((size_t)(b * NH + u.pn) * 128 + wc * 32 + 8 * fq + qi) * RPB + tile * 64 + slot0;
                  *(unsigned*)vp = t0; *(unsigned*)(vp + (size_t)4 * RPB) = t1; } }
    }
};
struct EpiQ8 {
    unsigned char* O; const float* cosT; const float* sinT;
    __device__ __forceinline__ void operator()(const Acc& acc, const Unit& u, int wr, int wc, int fr, int fq) const {
        asm volatile("" : "+v"(fr), "+v"(fq));
        const int row0 = u.pm * BM + wr * 64 + fr, col0 = u.pn * BM + wc * 32 + 8 * fq; constexpr float SQ = QK_C * (float)(1 << SH_QC);
        const int jt = u.pm % 17; const bool lat = jt != 0; const int pos0 = (jt - 1) * 256 + wr * 64 + fr;
#pragma unroll
        for (int bj = 0; bj < 2; ++bj) { const int c = col0 + bj * HALF, d = c % 192; const bool pe = lat && d >= 128; const int i0 = (d - 128) >> 1;
#pragma unroll
            for (int ai = 0; ai < 2; ++ai)
#pragma unroll
                for (int m = 0; m < 4; ++m) { f32x4 v0 = acc[ai][bj][m][0], v1 = acc[ai][bj][m][1];
                    if (pe) { const int pos = pos0 + ai * HALF + m * 16; const f32x4 cs = *(const f32x4*)(cosT + pos * 32 + i0), sn = *(const f32x4*)(sinT + pos * 32 + i0);
                        f32x4 r0, r1;
                        r0[0] = v0[0] * cs[0] - v0[1] * sn[0]; r0[1] = v0[1] * cs[0] + v0[0] * sn[0]; r0[2] = v0[2] * cs[1] - v0[3] * sn[1]; r0[3] = v0[3] * cs[1] + v0[2] * sn[1];
                        r1[0] = v1[0] * cs[2] - v1[1] * sn[2]; r1[1] = v1[1] * cs[2] + v1[0] * sn[2]; r1[2] = v1[2] * cs[3] - v1[3] * sn[3]; r1[3] = v1[3] * cs[3] + v1[2] * sn[3];
                        v0 = r0; v1 = r1; }
                    v0 = v0 * SQ; v1 = v1 * SQ; u32x2 o; o.x = pk_fp8x4(v0[0], v0[1], v0[2], v0[3]); o.y = pk_fp8x4(v1[0], v1[1], v1[2], v1[3]);
                    *(u32x2*)(O + (size_t)(row0 + ai * HALF + m * 16) * NQ + c) = o; } }
    }
};
struct EpiPool {
    bf16* O; const bf16* P; const float* pscale;
    __device__ __forceinline__ void operator()(const Acc& acc, const Unit& u, int wr, int wc, int fr, int fq) const {
        asm volatile("" : "+v"(fr), "+v"(fq));
        const int row0 = u.pm * BM + wr * 64 + fr, col0 = u.pn * BM + wc * 32 + 8 * fq;
        u32x4 gw[2][2][4];
#pragma unroll
        for (int bj = 0; bj < 2; ++bj)
#pragma unroll
            for (int ai = 0; ai < 2; ++ai)
#pragma unroll
                for (int m = 0; m < 4; ++m) gw[bj][ai][m] = *(const u32x4*)(P + (size_t)(row0 + ai * HALF + m * 16) * NP + P_GP + col0 + bj * HALF);
#pragma unroll
        for (int bj = 0; bj < 2; ++bj) { const int c = col0 + bj * HALF; const f32x4 s0 = *(const f32x4*)(pscale + c), s1 = *(const f32x4*)(pscale + c + 4);
#pragma unroll
            for (int ai = 0; ai < 2; ++ai) {
#pragma unroll
                for (int m = 0; m < 4; ++m) { const size_t r = (size_t)(row0 + ai * HALF + m * 16); f32x4 g0, g1; unpack8(gw[bj][ai][m], g0, g1);
                    *(u32x4*)(O + r * DM + c) = pack8(acc[ai][bj][m][0] * s0 * g0, acc[ai][bj][m][1] * s1 * g1); } } }
    }
};
struct EpiTri {
#if ATT_FP8
    EpiKV8 kv; EpiQ8 q; EpiPool pool;
#else
    EpiStore kv; EpiQ q; EpiPool pool;
#endif
    __device__ __forceinline__ void operator()(const Acc& acc, const Unit& u, int wr, int wc, int fr, int fq) const {
        if (u.kind == 0) kv(acc, u, wr, wc, fr, fq); else if (u.kind == 1) q(acc, u, wr, wc, fr, fq); else pool(acc, u, wr, wc, fr, fq);
    }
};
struct EpiNull { float* sink; __device__ __forceinline__ void operator()(const Acc& acc, const Unit& u, int wr, int wc, int fr, int fq) const {
        f32x4 t = {0, 0, 0, 0};
#pragma unroll
        for (int a = 0; a < 2; ++a)
#pragma unroll
            for (int b = 0; b < 2; ++b)
#pragma unroll
                for (int m = 0; m < 4; ++m)
#pragma unroll
                    for (int n = 0; n < 2; ++n) t += acc[a][b][m][n];
        if (t[0] + t[1] + t[2] + t[3] == 1.2345e33f) *sink = t[0]; } };
struct EpiKQ8 {
    EpiKV8 kv; EpiQ8 q;
    __device__ __forceinline__ void operator()(const Acc& acc, const Unit& u, int wr, int wc, int fr, int fq) const { if (u.kind == 0) kv(acc, u, wr, wc, fr, fq); else q(acc, u, wr, wc, fr, fq); }
};
struct EpiRes {
    const Frame* F; bool first; const float* gate;
    __device__ __forceinline__ void operator()(const Acc& acc, const Unit& u, int wr, int wc, int fr, int fq) const {
        asm volatile("" : "+v"(fr), "+v"(fq));
        const int row0 = u.pm * BM + wr * 64 + fr, col0 = u.pn * BM + wc * 32 + 8 * fq; const float* gr = gate + (size_t)mod_row(u.pm * BM) * NMOD;
#pragma unroll
        for (int bj = 0; bj < 2; ++bj) { const int c = col0 + bj * HALF; const f32x4 g0 = *(const f32x4*)(gr + c), g1 = *(const f32x4*)(gr + c + 4);
            if (first) {
#pragma unroll
                for (int ai = 0; ai < 2; ++ai) { f32x4 xf[4][2];
#pragma unroll
                    for (int m = 0; m < 4; ++m) { const float* src = xin_row(*F, row0 + ai * HALF + m * 16) + c; xf[m][0] = *(const f32x4*)src; xf[m][1] = *(const f32x4*)(src + 4); }
#pragma unroll
                    for (int m = 0; m < 4; ++m) *(u32x4*)(xres_row(*F, row0 + ai * HALF + m * 16) + c) = pack8(xf[m][0] + g0 * acc[ai][bj][m][0], xf[m][1] + g1 * acc[ai][bj][m][1]);
                    asm volatile("" ::: "memory"); } }
            else { u32x4 xb[2][4];
#pragma unroll
                for (int ai = 0; ai < 2; ++ai)
#pragma unroll
                    for (int m = 0; m < 4; ++m) xb[ai][m] = *(const u32x4*)(xres_row(*F, row0 + ai * HALF + m * 16) + c);
#pragma unroll
                for (int ai = 0; ai < 2; ++ai)
#pragma unroll
                    for (int m = 0; m < 4; ++m) { f32x4 x0, x1; unpack8(xb[ai][m], x0, x1);
                        *(u32x4*)(xres_row(*F, row0 + ai * HALF + m * 16) + c) = pack8(x0 + g0 * acc[ai][bj][m][0], x1 + g1 * acc[ai][bj][m][1]); } }
            asm volatile("" ::: "memory"); }
    }
};
struct EpiUp {
    unsigned char* Act; const volatile LAS float* cwa; const volatile LAS float* cwb;
    __device__ __forceinline__ void operator()(const Acc& acc, const Unit& u, int wr, int wc, int fr, int fq) const {
        asm volatile("" : "+v"(fr), "+v"(fq));
        const int seg = u.pn >> 2, lrow0 = wr * 64 + fr, hid0 = (u.pn & 3) * 128 + wc * 16 + 4 * fq;
#pragma unroll
        for (int ai = 0; ai < 2; ++ai)
#pragma unroll
            for (int m = 0; m < 4; ++m) { const int lr = lrow0 + ai * HALF + m * 16; const float w = seg == 0 ? 1.f : (seg == 1 ? cwa[u.slot * 256 + lr] : cwb[u.slot * 256 + lr]);
                unsigned char* rowp = Act + (size_t)(u.arow0 + lr) * NACT + seg * 512 + hid0; const float ws_ = w * (float)(1 << SH_ACT);
#pragma unroll
                for (int bj = 0; bj < 2; ++bj) { const f32x4 g = acc[ai][bj][m][0], up = acc[ai][bj][m][1]; f32x4 a;
#pragma unroll
                    for (int j = 0; j < 4; ++j) a[j] = ws_ * g[j] * sigmoidf_(g[j]) * up[j];
                    *(unsigned*)(rowp + bj * 64) = pk_fp8x4(a[0], a[1], a[2], a[3]); } }
    }
};
struct EpiDown {
    const Frame* F; const float* gate; const volatile LAS int* cidx; bool dry;
    __device__ __forceinline__ void operator()(const Acc& acc, const Unit& u, int wr, int wc, int fr, int fq) const {
        asm volatile("" : "+v"(fr), "+v"(fq));
        const int lrow0 = wr * 64 + fr, col0 = u.pn * BM + wc * 32 + 8 * fq;
#pragma unroll
        for (int ai = 0; ai < 2; ++ai) { int tok[4]; u32x4 xb[4][2];
#pragma unroll
            for (int m = 0; m < 4; ++m) { const int lr = lrow0 + ai * HALF + m * 16; tok[m] = (lr < u.nrows && !dry) ? cidx[u.slot * 256 + lr] : -1; }
#pragma unroll
            for (int m = 0; m < 4; ++m)
#pragma unroll
                for (int bj = 0; bj < 2; ++bj) if (tok[m] >= 0) xb[m][bj] = *(const u32x4*)(xres_row(*F, tok[m]) + col0 + bj * HALF);
#pragma unroll
            for (int m = 0; m < 4; ++m) {
                if (tok[m] >= 0) { bf16* xr = xres_row(*F, tok[m]); const float* gr = gate + (size_t)mod_row(tok[m]) * NMOD;
#pragma unroll
                    for (int bj = 0; bj < 2; ++bj) { const int c = col0 + bj * HALF; const f32x4 g0 = *(const f32x4*)(gr + c), g1 = *(const f32x4*)(gr + c + 4);
                        f32x4 x0, x1; unpack8(xb[m][bj], x0, x1);
                        *(u32x4*)(xr + c) = pack8(x0 + g0 * acc[ai][bj][m][0], x1 + g1 * acc[ai][bj][m][1]); } } }
            asm volatile("" ::: "memory"); }
    }
};
}

namespace att {
constexpr int NW = 8, QBLK = 32, KVBLK = 64;
constexpr float SCALE = 0.07216878364870322f;
constexpr float THR = 8.f;
constexpr int LDQ = NQ, LDK = NKV, LDP = 64;
constexpr int SHM_V = KVBLK * 128 * 2, SHM_K = KVBLK * 128 * 2, SHM_P = KVBLK * 64 * 2;
constexpr int OFF_V = 0, OFF_K = 2 * SHM_V, OFF_P = OFF_K + 2 * SHM_K, OFF_WS = OFF_P + 2 * SHM_P;
#define KSWZ(row, colB) ((row) * 256 + ((colB) ^ (((row) & 7) << 4)))
#define PSWZ(row, colB) ((row) * 128 + ((colB) ^ (((row) & 7) << 4)))
#define SBAR() __builtin_amdgcn_sched_barrier(0)
__device__ __forceinline__ int crow(int r, int hi) { return (r & 3) + 8 * (r >> 2) + 4 * hi; }
__device__ __forceinline__ unsigned cvtpk(float lo, float hi) { unsigned r; asm volatile("v_cvt_pk_bf16_f32 %0, %1, %2" : "=v"(r) : "v"(lo), "v"(hi)); return r; }

__device__ __forceinline__ void partialSM(f32x16& p0, f32x16& p1, float& m_reg, float& mn, float& alpha) {
  constexpr float C = SCALE * 1.4426950408889634f;
  float pmax = p0[0];
#pragma unroll
  for (int r = 1; r < 16; ++r) pmax = fmaxf(pmax, p0[r]);
#pragma unroll
  for (int r = 0; r < 16; ++r) pmax = fmaxf(pmax, p1[r]);
  { auto rr = __builtin_amdgcn_permlane32_swap(__float_as_uint(pmax), __float_as_uint(pmax), false, false);
    pmax = fmaxf(__uint_as_float(rr[0]), __uint_as_float(rr[1])); }
  if (__builtin_expect(__all(pmax - m_reg <= THR / SCALE), 1)) { mn = m_reg; alpha = 1.f; }
  else { mn = fmaxf(m_reg, pmax); alpha = __builtin_amdgcn_exp2f((m_reg - mn) * C); m_reg = mn; }
  float mnC = -mn * C;
#pragma unroll
  for (int r = 0; r < 16; ++r) p0[r] = fmaf(p0[r], C, mnC);
#pragma unroll
  for (int r = 0; r < 16; ++r) p1[r] = fmaf(p1[r], C, mnC);
#pragma unroll
  for (int r = 0; r < 16; ++r) p0[r] = __builtin_amdgcn_exp2f(p0[r]);
}
__device__ __forceinline__ void finishSM(f32x16& p0, f32x16& p1, float alpha, float& l_reg, bf16x8& pa0, bf16x8& pa1, bf16x8& pa2, bf16x8& pa3) {
#pragma unroll
  for (int r = 0; r < 16; ++r) p1[r] = __builtin_amdgcn_exp2f(p1[r]);
  float ps = 0;
#pragma unroll
  for (int r = 0; r < 16; ++r) ps += p0[r];
#pragma unroll
  for (int r = 0; r < 16; ++r) ps += p1[r];
  { auto rr = __builtin_amdgcn_permlane32_swap(__float_as_uint(ps), __float_as_uint(ps), false, false);
    ps = __uint_as_float(rr[0]) + __uint_as_float(rr[1]); }
  l_reg = l_reg * alpha + ps;
#define PK4(P, BASE, OUT) do { unsigned a0 = cvtpk(P[BASE + 0], P[BASE + 1]), a1 = cvtpk(P[BASE + 2], P[BASE + 3]);   \
    unsigned b0 = cvtpk(P[BASE + 4], P[BASE + 5]), b1 = cvtpk(P[BASE + 6], P[BASE + 7]);                              \
    auto r0 = __builtin_amdgcn_permlane32_swap(a0, b0, false, false); auto r1 = __builtin_amdgcn_permlane32_swap(a1, b1, false, false); \
    u32x4 w = {r0[0], r1[0], r0[1], r1[1]}; OUT = *reinterpret_cast<bf16x8*>(&w); } while (0)
  PK4(p0, 0, pa0); PK4(p0, 8, pa1); PK4(p1, 0, pa2); PK4(p1, 8, pa3);
#undef PK4
}
__device__ __forceinline__ void qkt(f32x16& p0, f32x16& p1, const char* Ks, const char* Ps, const bf16x8* qr, int r32, int hi) {
  p0 = f32x16{}; p1 = f32x16{};
#pragma unroll
  for (int d0 = 0; d0 < 8; ++d0) { int cb = (d0 * 16 + hi * 8) * 2;
    bf16x8 b0 = *reinterpret_cast<const bf16x8*>(Ks + KSWZ(r32, cb));
    bf16x8 b1 = *reinterpret_cast<const bf16x8*>(Ks + KSWZ(32 + r32, cb));
    p0 = __builtin_amdgcn_mfma_f32_32x32x16_bf16(b0, qr[d0], p0, 0, 0, 0);
    p1 = __builtin_amdgcn_mfma_f32_32x32x16_bf16(b1, qr[d0], p1, 0, 0, 0); }
#pragma unroll
  for (int d0 = 0; d0 < 4; ++d0) { int cb = (d0 * 16 + hi * 8) * 2;
    bf16x8 b0 = *reinterpret_cast<const bf16x8*>(Ps + PSWZ(r32, cb));
    bf16x8 b1 = *reinterpret_cast<const bf16x8*>(Ps + PSWZ(32 + r32, cb));
    p0 = __builtin_amdgcn_mfma_f32_32x32x16_bf16(b0, qr[8 + d0], p0, 0, 0, 0);
    p1 = __builtin_amdgcn_mfma_f32_32x32x16_bf16(b1, qr[8 + d0], p1, 0, 0, 0); }
}
__device__ __forceinline__ int v_st(int k, int c) { const int kk = (k & ~0xC) | ((k & 4) << 1) | ((k & 8) >> 1); return ((kk >> 3) * 4 + (c >> 5)) * 512 + ((kk & 7) * 32 + (c & 31)) * 2; }
__device__ __forceinline__ int v_rd_base(int lane) { return ((lane & 3) << 3) | (((lane >> 2) & 3) << 6) | (((lane >> 4) & 1) << 5) | (((lane >> 5) & 1) << 8); }
constexpr int v_rd_off(int d0, int ks, int half) { return d0 * 512 + ks * 4096 + half * 2048; }
template <int OFF> __device__ __forceinline__ s16x4 tr_read(int vb) {
  s16x4 r; asm volatile("ds_read_b64_tr_b16 %0, %1 offset:%2" : "=&v"(r) : "v"(vb), "i"(OFF) : "memory"); return r;
}
template <int D0> __device__ __forceinline__ void pv_one(f32x16& od, int vb, bf16x8 pa0, bf16x8 pa1, bf16x8 pa2, bf16x8 pa3) {
  const s16x4 l0 = tr_read<v_rd_off(D0, 0, 0)>(vb), h0 = tr_read<v_rd_off(D0, 0, 1)>(vb), l1 = tr_read<v_rd_off(D0, 1, 0)>(vb), h1 = tr_read<v_rd_off(D0, 1, 1)>(vb);
  const s16x4 l2 = tr_read<v_rd_off(D0, 2, 0)>(vb), h2 = tr_read<v_rd_off(D0, 2, 1)>(vb), l3 = tr_read<v_rd_off(D0, 3, 0)>(vb), h3 = tr_read<v_rd_off(D0, 3, 1)>(vb);
  asm volatile("s_waitcnt lgkmcnt(0)" ::: "memory"); SBAR();
#define PK(L, H) (bf16x8){L[0], L[1], L[2], L[3], H[0], H[1], H[2], H[3]}
  od = __builtin_amdgcn_mfma_f32_32x32x16_bf16(pa0, PK(l0, h0), od, 0, 0, 0);
  od = __builtin_amdgcn_mfma_f32_32x32x16_bf16(pa1, PK(l1, h1), od, 0, 0, 0);
  od = __builtin_amdgcn_mfma_f32_32x32x16_bf16(pa2, PK(l2, h2), od, 0, 0, 0);
  od = __builtin_amdgcn_mfma_f32_32x32x16_bf16(pa3, PK(l3, h3), od, 0, 0, 0);
#undef PK
}
__device__ __forceinline__ void pv_d0(f32x16* o, int vb, bf16x8 pa0, bf16x8 pa1, bf16x8 pa2, bf16x8 pa3) {
  pv_one<0>(o[0], vb, pa0, pa1, pa2, pa3); pv_one<1>(o[1], vb, pa0, pa1, pa2, pa3); pv_one<2>(o[2], vb, pa0, pa1, pa2, pa3); pv_one<3>(o[3], vb, pa0, pa1, pa2, pa3);
}
__device__ __forceinline__ void attn_unit(const bf16* __restrict__ Qb, const bf16* __restrict__ Kh, const bf16* __restrict__ Vh, const bf16* __restrict__ Kp,
                                          bf16* Mx, const bf16* Gt, int seq, char* lds, bool dry, const int wave) {
  int tid = tid_from(wave); asm volatile("" : "+v"(tid));
  const int wid = wave, lane = tid & 63, r32 = lane & 31, hi = lane >> 5;
  char* V_lds = lds + OFF_V; char* K_lds = lds + OFF_K; char* P_lds = lds + OFF_P;
  float* ws = (float*)(lds + OFF_WS) + wid * 64; float* li_l = ws; float* al_l = ws + 32;
  float m_reg = -1e30f, l_reg = 0; f32x16 o[4] = {}; bf16x8 qr[12];
  __syncthreads();
  const bf16* Qw = Qb + (long)(wid * QBLK + r32) * LDQ + hi * 8;
#pragma unroll
  for (int d0 = 0; d0 < 12; ++d0) qr[d0] = *reinterpret_cast<const bf16x8*>(Qw + d0 * 16);
  const int sr = tid >> 4, sc = (tid & 15) * 8, vst0 = v_st(sr, sc), vst1 = v_st(32 + sr, sc);
  const int pr = tid >> 3, pc = (tid & 7) * 8;
  const int vb0 = (int)(uintptr_t)V_lds + v_rd_base(lane);
#ifndef ATT_SDEPTH
#define ATT_SDEPTH 1
#endif
  struct { bf16x8 vs0, vs1, ks0, ks1, ps; } sr_[ATT_SDEPTH];
  const unsigned off0 = (unsigned)(sr * LDK + sc) * 2u, offp = (unsigned)(pr * LDP + pc) * 2u;
#define SLOAD(i, k0) do { const char* kb_ = (const char*)Kh + (size_t)(k0) * (LDK * 2); const char* vb_ = (const char*)Vh + (size_t)(k0) * (LDK * 2); \
    sr_[i].vs0 = *(const bf16x8*)(vb_ + off0); sr_[i].vs1 = *(const bf16x8*)(vb_ + 32 * LDK * 2 + off0); \
    sr_[i].ks0 = *(const bf16x8*)(kb_ + off0); sr_[i].ks1 = *(const bf16x8*)(kb_ + 32 * LDK * 2 + off0); \
    sr_[i].ps = *(const bf16x8*)((const char*)Kp + (size_t)(k0) * (LDP * 2) + offp); } while (0)
#define SWRITE(b, i) do { *(bf16x8*)(V_lds + (b) * SHM_V + vst0) = sr_[i].vs0; *(bf16x8*)(V_lds + (b) * SHM_V + vst1) = sr_[i].vs1; int kc = sc * 2;  \
    *(bf16x8*)(K_lds + (b) * SHM_K + KSWZ(sr, kc)) = sr_[i].ks0; *(bf16x8*)(K_lds + (b) * SHM_K + KSWZ(32 + sr, kc)) = sr_[i].ks1;                    \
    *(bf16x8*)(P_lds + (b) * SHM_P + PSWZ(pr, pc * 2)) = sr_[i].ps; } while (0)
#if ATT_SDEPTH == 2
#define SWAIT() asm volatile("s_waitcnt vmcnt(5)" ::: "memory")
#else
#define SWAIT() asm volatile("s_waitcnt vmcnt(0)" ::: "memory")
#endif
#define RESC(a) do { if (__any((a) < 1.f)) { if (hi == 0) al_l[r32] = (a); asm volatile("s_waitcnt lgkmcnt(0)" ::: "memory"); \
    _Pragma("unroll") for (int d = 0; d < 4; ++d) _Pragma("unroll") for (int r = 0; r < 16; ++r) o[d][r] *= al_l[crow(r, hi)]; } } while (0)
  f32x16 pA0, pA1, pB0, pB1; float mnA, mnB, alA, alB; bf16x8 pa0, pa1, pa2, pa3; const int NT = seq / KVBLK;
  constexpr int SE = 0, SO = ATT_SDEPTH - 1;
  SLOAD(SE, 0); asm volatile("s_waitcnt vmcnt(0)" ::: "memory"); SWRITE(0, SE); __syncthreads();
  qkt(pA0, pA1, K_lds, P_lds, qr, r32, hi); partialSM(pA0, pA1, m_reg, mnA, alA);
  SLOAD(SO, KVBLK); if (ATT_SDEPTH == 2 && 2 < NT) SLOAD(SE, 2 * KVBLK);
  SWAIT(); SWRITE(1, SO); __syncthreads();
  for (int j = 1; j + 1 < NT; j += 2) {
    SBAR(); qkt(pB0, pB1, K_lds + SHM_K, P_lds + SHM_P, qr, r32, hi);
    finishSM(pA0, pA1, alA, l_reg, pa0, pa1, pa2, pa3); SBAR();
    SLOAD(SO, (j + ATT_SDEPTH) * KVBLK); SBAR();
    pv_d0(o, vb0, pa0, pa1, pa2, pa3); partialSM(pB0, pB1, m_reg, mnB, alB);
    __syncthreads(); SWAIT(); SWRITE(0, SE);
    RESC(alB); __syncthreads();
    SBAR(); qkt(pA0, pA1, K_lds, P_lds, qr, r32, hi);
    finishSM(pB0, pB1, alB, l_reg, pa0, pa1, pa2, pa3); SBAR();
    if (ATT_SDEPTH == 1 || j + 3 < NT) SLOAD(SE, (j + 1 + ATT_SDEPTH) * KVBLK); SBAR();
    pv_d0(o, vb0 + (int)SHM_V, pa0, pa1, pa2, pa3); partialSM(pA0, pA1, m_reg, mnA, alA);
    __syncthreads(); SWAIT(); SWRITE(1, SO);
    RESC(alA); __syncthreads();
  }
  SBAR(); qkt(pB0, pB1, K_lds + SHM_K, P_lds + SHM_P, qr, r32, hi);
  finishSM(pA0, pA1, alA, l_reg, pa0, pa1, pa2, pa3); SBAR();
  pv_d0(o, vb0, pa0, pa1, pa2, pa3); partialSM(pB0, pB1, m_reg, mnB, alB);
  __syncthreads(); RESC(alB);
  finishSM(pB0, pB1, alB, l_reg, pa0, pa1, pa2, pa3); SBAR();
  pv_d0(o, vb0 + (int)SHM_V, pa0, pa1, pa2, pa3);
  if (hi == 0) li_l[r32] = l_reg; asm volatile("s_waitcnt lgkmcnt(0)" ::: "memory");
  float rli[16];
#pragma unroll
  for (int r = 0; r < 16; ++r) rli[r] = __builtin_amdgcn_rcpf(li_l[crow(r, hi)]);
  __syncthreads();
  float* ep = (float*)(lds + wid * (32 * 132 * 4));
#pragma unroll
  for (int r = 0; r < 16; ++r)
#pragma unroll
    for (int d0 = 0; d0 < 4; ++d0) ep[crow(r, hi) * 132 + d0 * 32 + r32] = o[d0][r] * rli[r];
  asm volatile("s_waitcnt lgkmcnt(0)" ::: "memory");
  int lane2 = lane_now();
#pragma unroll 2
  for (int it = 0; it < 8; ++it) { const int item = it * 64 + lane2, row = item >> 4, ch = item & 15; const long orow = wid * QBLK + row;
    const f32x4 y0 = *(const f32x4*)(ep + row * 132 + ch * 8), y1 = *(const f32x4*)(ep + row * 132 + ch * 8 + 4);
    f32x4 g0, g1, m0, m1; pg8::unpack8(*(const u32x4*)(Gt + orow * NP + ch * 8), g0, g1); pg8::unpack8(*(const u32x4*)(Mx + orow * DM + ch * 8), m0, m1);
    if (!dry) *(u32x4*)(Mx + orow * DM + ch * 8) = pg8::pack8(g0 * y0 + m0, g1 * y1 + m1); }
#if PROBE_ATTN
  bf16* dbg = *(bf16* volatile*)(lds + L_MISC + 64);
#else
  bf16* dbg = nullptr;
#endif
  if (dbg) {
    const int lane3 = lane_now(), wid3 = wid; const float* ep3 = (const float*)(lds + wid3 * (32 * 132 * 4));
#pragma unroll 1
    for (int it = 0; it < 8; ++it) { const int item = it * 64 + lane3, row = item >> 4, ch = item & 15;
      const f32x4 y0 = *(const f32x4*)(ep3 + row * 132 + ch * 8), y1 = *(const f32x4*)(ep3 + row * 132 + ch * 8 + 4);
      *(u32x4*)(dbg + (long)(wid3 * QBLK + row) * 128 + ch * 8) = pg8::pack8(y0, y1); } }
#undef SLOAD
#undef SWRITE
#undef SWAIT
#undef RESC
}
}


namespace att8 {
using att::crow; using att::cvtpk;
#ifndef PROBE_ABL
#define PROBE_ABL 0
#endif
constexpr int KVBLK = 64, QBLK = 32;
constexpr float SCALE = 0.07216878364870322f;
constexpr float THR = 3.f;
constexpr int KP = 208, VP = 80;
constexpr int SHM_K = KVBLK * KP, SHM_V = 128 * VP;
constexpr int NBUF = 4;
constexpr int OFF_K = 0, OFF_V = NBUF * SHM_K, OFF_WS = OFF_V + NBUF * SHM_V, OFF_QS = OFF_WS + 2048;
#define A8_CAT(lo, hi) __builtin_shufflevector(lo, hi, 0, 1, 2, 3, 4, 5, 6, 7)
__device__ __forceinline__ i32x8 ld32(const char* p) { const i32x4 lo = *(const i32x4*)p, hi = *(const i32x4*)(p + 16); return A8_CAT(lo, hi); }
__device__ __forceinline__ void partialSM(f32x16& p0, f32x16& p1, f32x16& negm, float& alpha, const bool first, const bool abl = false) {
  if (PROBE_ABL == 2 && abl) { alpha = 1.f; return; }
  constexpr float T2 = THR * 1.4426950408889634f;
  float pmax = __builtin_fmaxf(p0[0], p1[0]);
#pragma unroll
  for (int r = 1; r < 16; ++r) pmax = __builtin_fmaxf(__builtin_fmaxf(pmax, p0[r]), p1[r]);
  { auto rr = __builtin_amdgcn_permlane32_swap(__float_as_uint(pmax), __float_as_uint(pmax), false, false);
    pmax = fmaxf(__uint_as_float(rr[0]), __uint_as_float(rr[1])); }
  const float over = pmax - (float)SH_P;
  if (__builtin_expect(!first && __all(over <= T2), 1)) { alpha = 1.f; }
  else { const float delta = first ? over : fmaxf(over, 0.f); alpha = first ? 0.f : __builtin_amdgcn_exp2f(-delta);
#pragma unroll
    for (int r = 0; r < 16; ++r) { p0[r] -= delta; p1[r] -= delta; negm[r] -= delta; } }
  if (PROBE_ABL == 1 && abl) return;
#pragma unroll
  for (int r = 0; r < 16; ++r) p0[r] = __builtin_amdgcn_exp2f(p0[r]);
}
__device__ __forceinline__ void finishSM(f32x16& p0, f32x16& p1, float& l_reg, i32x8& pa, const bool abl = false) {
  if (PROBE_ABL == 2 && abl) return;
  if (!(PROBE_ABL == 1 && abl)) {
#pragma unroll
  for (int r = 0; r < 16; ++r) p1[r] = __builtin_amdgcn_exp2f(p1[r]); }
  float ps = 0;
#pragma unroll
  for (int r = 0; r < 16; ++r) ps += p0[r];
#pragma unroll
  for (int r = 0; r < 16; ++r) ps += p1[r];
  { auto rr = __builtin_amdgcn_permlane32_swap(__float_as_uint(ps), __float_as_uint(ps), false, false);
    ps = __uint_as_float(rr[0]) + __uint_as_float(rr[1]); }
  l_reg += ps;
#pragma unroll
  for (int w = 0; w < 4; ++w) { int x = __float_as_int(p0[4 * w]);
    x = __builtin_amdgcn_cvt_pk_fp8_f32(p0[4 * w], p0[4 * w + 1], x, false); x = __builtin_amdgcn_cvt_pk_fp8_f32(p0[4 * w + 2], p0[4 * w + 3], x, true); pa[w] = x; }
#pragma unroll
  for (int w = 0; w < 4; ++w) { int x = __float_as_int(p1[4 * w]);
    x = __builtin_amdgcn_cvt_pk_fp8_f32(p1[4 * w], p1[4 * w + 1], x, false); x = __builtin_amdgcn_cvt_pk_fp8_f32(p1[4 * w + 2], p1[4 * w + 3], x, true); pa[4 + w] = x; }
}
__device__ __forceinline__ void ldk0(i32x8 (&pre)[4], const char* Ks, int r32, int hi) { pre[0] = ld32(Ks + r32 * KP + 32 * hi); pre[1] = ld32(Ks + (32 + r32) * KP + 32 * hi); pre[2] = ld32(Ks + r32 * KP + 64 + 32 * hi); pre[3] = ld32(Ks + (32 + r32) * KP + 64 + 32 * hi); }
__device__ __forceinline__ void qkt(f32x16& p0, f32x16& p1, const char* Ks, const i32x8* qf, const i32x8 (&pre)[4], const f32x16& negm, int r32, int hi, const bool abl = false) {
  if (PROBE_ABL == 5 && abl) { p0 = negm; p1 = negm; return; }
  constexpr int scK = (127 - SH_K) * 0x01010101, scQ = (127 - SH_QC) * 0x01010101;
#pragma unroll
  for (int s = 0; s < 3; ++s) { i32x8 a0, a1; if (s < 2) { a0 = pre[2 * s]; a1 = pre[2 * s + 1]; } else { a0 = ld32(Ks + r32 * KP + 64 * s + 32 * hi); a1 = ld32(Ks + (32 + r32) * KP + 64 * s + 32 * hi); }
    const i32x8 q = qf[s];
    p0 = __builtin_amdgcn_mfma_scale_f32_32x32x64_f8f6f4(a0, q, s == 0 ? negm : p0, 0, 0, 0, scK, 0, scQ);
    p1 = __builtin_amdgcn_mfma_scale_f32_32x32x64_f8f6f4(a1, q, s == 0 ? negm : p1, 0, 0, 0, scK, 0, scQ);
    if (s < 2) __builtin_amdgcn_sched_barrier(0x406); }
}
__device__ __forceinline__ void pv(f32x16* o, const char* Vs, const i32x8& pa, int r32, int hi, const bool abl = false) {
  if (PROBE_ABL == 5 && abl) return;
  constexpr int scP = (127 - SH_P) * 0x01010101, scV = (127 - SH_V) * 0x01010101;
#pragma unroll
  for (int d0 = 0; d0 < 4; ++d0) { const i32x8 b = ld32(Vs + (32 * d0 + r32) * VP + 32 * hi);
    o[d0] = __builtin_amdgcn_mfma_scale_f32_32x32x64_f8f6f4(pa, b, o[d0], 0, 0, 0, scP, 0, scV); }
}
__device__ __forceinline__ void attn_unit(const unsigned char* __restrict__ Q8, const unsigned char* __restrict__ K8, const unsigned char* __restrict__ KP8, const unsigned char* __restrict__ VT,
                                          const bf16* Mx, const bf16* Gt, unsigned char* M8, int seq, char* lds, bool dry, const int wave) {
  int tid = tid_from(wave); asm volatile("" : "+v"(tid));
  const int wid = wave, lane = tid & 63, r32 = lane & 31, hi = lane >> 5;
  char* K_lds = lds + OFF_K; char* V_lds = lds + OFF_V;
  float* ws = (float*)(lds + OFF_WS) + wid * 64; float* li_l = ws; float* al_l = ws + 32;
  float l_reg = 0; f32x16 o[4] = {}; f32x16 negm; i32x8 qf[3];
#pragma unroll
  for (int r = 0; r < 16; ++r) negm[r] = (float)SH_P;
  __syncthreads();
  char* qsp = lds + OFF_QS + wid * 6144 + lane * 16;
  { const char* qp = (const char*)Q8 + (size_t)(wid * QBLK + r32) * NQ + 32 * hi;
#pragma unroll
    for (int s = 0; s < 3; ++s) { const i32x4 lo = *(const i32x4*)(qp + 64 * s), hi4 = *(const i32x4*)(qp + 64 * s + 16); qf[s] = A8_CAT(lo, hi4); } }
  unsigned offk = (unsigned)((tid >> 3) * DM + 16 * (tid & 7)), offv = (unsigned)((tid >> 2) * RPB + 16 * (tid & 3)); int wk = (tid >> 3) * KP + 16 * (tid & 7), wv = (tid >> 2) * VP + 16 * (tid & 3);
  asm volatile("" : "+v"(offk), "+v"(offv), "+v"(wk), "+v"(wv));
#ifndef ATT8_SDEPTH
#define ATT8_SDEPTH 2
#endif
  struct { u32x4 kn, vt; u32x2 kp; } sr_[ATT8_SDEPTH];
#define A8_G(T) const __attribute__((address_space(1))) T*
#define SLOAD(i, k0) do { if (PROBE_ABL == 42 && dry) break; const char* kb_ = (const char*)K8 + (size_t)(k0) * DM; const char* pb_ = (const char*)KP8 + (size_t)(k0) * 64; const char* vb_ = (const char*)VT + (size_t)(k0); \
    asm volatile("" : "+s"(kb_), "+s"(pb_), "+s"(vb_), "+v"(offk), "+v"(offv)); \
    sr_[i].kn = *(A8_G(u32x4))((A8_G(char))kb_ + offk); { unsigned op_ = (unsigned)(tid * 8); asm volatile("" : "+v"(op_)); sr_[i].kp = *(A8_G(u32x2))((A8_G(char))pb_ + op_); } sr_[i].vt = *(A8_G(u32x4))((A8_G(char))vb_ + offv); } while (0)
#define SWRITE(b, i) do { if (PROBE_ABL == 41 && dry) break; char* kd_ = K_lds + (b) * SHM_K; *(u32x4*)(kd_ + wk) = sr_[i].kn; *(u32x2*)(kd_ + wk + 128 - 8 * (tid & 7)) = sr_[i].kp; \
    *(u32x4*)(V_lds + (b) * SHM_V + wv) = sr_[i].vt; } while (0)
#if ATT8_SDEPTH == 2
#define SWAIT() asm volatile("s_waitcnt vmcnt(3)" ::: "memory")
#else
#define SWAIT() asm volatile("s_waitcnt vmcnt(0)" ::: "memory")
#endif
#define RESC(a) do { if (__any((a) < 1.f)) { l_reg *= (a); if (hi == 0) al_l[r32] = (a); asm volatile("s_waitcnt lgkmcnt(0)" ::: "memory"); \
    _Pragma("unroll") for (int d = 0; d < 4; ++d) _Pragma("unroll") for (int r = 0; r < 16; ++r) o[d][r] *= al_l[crow(r, hi)]; } } while (0)
  f32x16 pA0, pA1, pB0, pB1; float alA, alB; i32x8 pa; const int NT = seq / KVBLK;
  constexpr int SE = 0, SO = ATT8_SDEPTH - 1;
#define TCL(t) (min((t), NT - 1) * KVBLK)
  i32x8 pre[4];
#define A8_BAR() do { asm volatile("s_waitcnt lgkmcnt(8)" ::: "memory"); __builtin_amdgcn_s_barrier(); asm volatile("" ::: "memory"); } while (0)
  if (wid >= 4) __builtin_amdgcn_s_setprio(1);
  SLOAD(SE, 0); SLOAD(SO, TCL(1)); asm volatile("s_waitcnt vmcnt(0)" ::: "memory"); SWRITE(0, SE); SWRITE(1, SO); __syncthreads();
  SLOAD(SE, TCL(2));
  ldk0(pre, K_lds, r32, hi); qkt(pA0, pA1, K_lds, qf, pre, negm, r32, hi, dry); partialSM(pA0, pA1, negm, alA, true, dry);
  SLOAD(SO, TCL(3));
  SWAIT(); SWRITE(2, SE); asm volatile("" ::: "memory"); ldk0(pre, K_lds + SHM_K, r32, hi); A8_BAR();
  for (int j = 1; j + 1 < NT; j += 2) {
    SBAR(); qkt(pB0, pB1, K_lds + (j & 3) * SHM_K, qf, pre, negm, r32, hi, dry);
    finishSM(pA0, pA1, l_reg, pa, dry); SBAR();
    SLOAD(SE, TCL(j + 3)); SBAR();
    pv(o, V_lds + ((j - 1) & 3) * SHM_V, pa, r32, hi, dry); partialSM(pB0, pB1, negm, alB, false, dry);
    SWAIT(); SWRITE((j + 2) & 3, SO); RESC(alB); asm volatile("" ::: "memory"); ldk0(pre, K_lds + ((j + 1) & 3) * SHM_K, r32, hi);
    A8_BAR();
    SBAR(); qkt(pA0, pA1, K_lds + ((j + 1) & 3) * SHM_K, qf, pre, negm, r32, hi, dry);
    finishSM(pB0, pB1, l_reg, pa, dry); SBAR();
    SLOAD(SO, TCL(j + 4)); SBAR();
    pv(o, V_lds + (j & 3) * SHM_V, pa, r32, hi, dry); partialSM(pA0, pA1, negm, alA, false, dry);
    SWAIT(); SWRITE((j + 3) & 3, SE); RESC(alA); asm volatile("" ::: "memory"); ldk0(pre, K_lds + ((j + 2) & 3) * SHM_K, r32, hi);
    A8_BAR();
  }
  SBAR(); qkt(pB0, pB1, K_lds + ((NT - 1) & 3) * SHM_K, qf, pre, negm, r32, hi, dry);
  finishSM(pA0, pA1, l_reg, pa, dry); SBAR();
  pv(o, V_lds + ((NT - 2) & 3) * SHM_V, pa, r32, hi, dry); partialSM(pB0, pB1, negm, alB, false, dry);
  RESC(alB);
  finishSM(pB0, pB1, l_reg, pa, dry); SBAR();
  pv(o, V_lds + ((NT - 1) & 3) * SHM_V, pa, r32, hi, dry);
  asm volatile("s_waitcnt vmcnt(0)" ::: "memory");
#undef TCL
#undef A8_BAR
  __builtin_amdgcn_s_setprio(0);
  if (hi == 0) li_l[r32] = l_reg * (1.f / (float)(1 << SH_P)); asm volatile("s_waitcnt lgkmcnt(0)" ::: "memory");
  float rli[16];
#pragma unroll
  for (int r = 0; r < 16; ++r) rli[r] = __builtin_amdgcn_rcpf(li_l[crow(r, hi)]);
  __syncthreads();
  float* ep = (float*)(lds + wid * (32 * 132 * 4));
#pragma unroll
  for (int r = 0; r < 16; ++r)
#pragma unroll
    for (int d0 = 0; d0 < 4; ++d0) ep[crow(r, hi) * 132 + d0 * 32 + r32] = o[d0][r] * rli[r];
  asm volatile("s_waitcnt lgkmcnt(0)" ::: "memory");
  const int lane2 = lane_now();
#pragma unroll 2
  for (int it = 0; it < 8; ++it) { const int item = it * 64 + lane2, row = item >> 4, ch = item & 15; const long orow = wid * QBLK + row;
    const f32x4 y0 = *(const f32x4*)(ep + row * 132 + ch * 8), y1 = *(const f32x4*)(ep + row * 132 + ch * 8 + 4);
    f32x4 g0, g1, m0, m1; pg8::unpack8(*(const u32x4*)(Gt + orow * NP + ch * 8), g0, g1); pg8::unpack8(*(const u32x4*)(Mx + orow * DM + ch * 8), m0, m1);
    constexpr float SM = (float)(1 << SH_MIX); const f32x4 z0 = (g0 * y0 + m0) * SM, z1 = (g1 * y1 + m1) * SM;
    u32x2 w; w.x = pk_fp8x4(z0[0], z0[1], z0[2], z0[3]); w.y = pk_fp8x4(z1[0], z1[1], z1[2], z1[3]);
    if (!dry) *(u32x2*)(M8 + orow * DM + ch * 8) = w; }
#if PROBE_ATTN
  { bf16* dbg = *(bf16* volatile*)(lds + L_MISC + 64);
    if (dbg) { const int lane3 = lane_now(); const float* ep3 = (const float*)(lds + wid * (32 * 132 * 4));
#pragma unroll 1
      for (int it = 0; it < 8; ++it) { const int item = it * 64 + lane3, row = item >> 4, ch = item & 15;
        const f32x4 y0 = *(const f32x4*)(ep3 + row * 132 + ch * 8), y1 = *(const f32x4*)(ep3 + row * 132 + ch * 8 + 4);
        *(u32x4*)(dbg + (long)(wid * QBLK + row) * 128 + ch * 8) = pg8::pack8(y0, y1); } } }
#endif
#undef SLOAD
#undef SWRITE
#undef SWAIT
#undef RESC
#undef A8_G
}
#undef A8_CAT
}

__device__ __forceinline__ int srcbase1(int n0) { if (n0 < 512) return n0; if (n0 < 896) return 576 + (n0 - 512); if (n0 < 960) return 512 + (n0 - 896); if (n0 < 1024) return -1; if (n0 < 2048) return 960 + (n0 - 1024); return 1984 + (n0 - 2048); }
struct ItemDesc { const float* W; const float* W2; bf16* WT; int K, srcN, kind, item, nblk, fp8sh, ksrc; };
__device__ __forceinline__ void item_load(const ItemDesc& d, int lane, f32x4 (&v)[16]) {
    const int kb = d.item / d.nblk, nb = d.item - kb * d.nblk, k0 = 64 * kb, n0 = 64 * nb;
    const int jq = lane & 15, ks = lane >> 4;
    const float* src = d.W; int sc;
    if (d.kind == 3) { src = jq < 8 ? d.W : d.W2; sc = 32 * nb + 4 * (jq & 7); }
    else { const int base = d.kind == 1 ? srcbase1(n0) : n0; sc = base < 0 ? -1 : base + 4 * jq; }
    if (k0 >= d.ksrc) sc = -1;
#pragma unroll
    for (int i = 0; i < 16; ++i) v[i] = sc >= 0 ? __builtin_nontemporal_load((const f32x4*)(src + (size_t)(k0 + 4 * i + ks) * d.srcN + sc)) : (f32x4){0.f, 0.f, 0.f, 0.f};
}
__device__ __forceinline__ void item_finish(const ItemDesc& d, int lane, LAS float* scr, const f32x4 (&v)[16]) {
    const int kb = d.item / d.nblk, nb = d.item - kb * d.nblk, k0 = 64 * kb, n0 = 64 * nb, K = d.K, kind = d.kind;
    const int jq = lane & 15, ks = lane >> 4;
#pragma unroll
    for (int i = 0; i < 16; ++i)
#pragma unroll
        for (int e = 0; e < 4; ++e) scr[(4 * jq + e) * 65 + 4 * i + ks] = v[i][e];
    LDS_WAIT(); asm volatile("" ::: "memory");
    if (d.fp8sh >= 0) {
        const int c4 = lane & 3; const float sc_ = (float)(1 << d.fp8sh); unsigned char* W8 = (unsigned char*)d.WT;
        const bool perm2f = (kind == 2) && (nb % 3 == 2);
#pragma unroll
        for (int jj = 0; jj < 4; ++jj) { const int nn = (lane >> 2) + 16 * jj; int lcol = nn;
            if (perm2f) lcol = (nn & 1) ? 32 + (nn >> 1) : (nn >> 1);
            if (kind == 3) { const int q = nn >> 3, w = nn & 7; lcol = w < 4 ? 4 * q + w : 32 + 4 * q + (w - 4); }
            const LAS float* p = scr + lcol * 65 + 16 * c4;
            u32x4 o; o.x = pk_fp8x4(p[0] * sc_, p[1] * sc_, p[2] * sc_, p[3] * sc_); o.y = pk_fp8x4(p[4] * sc_, p[5] * sc_, p[6] * sc_, p[7] * sc_);
            o.z = pk_fp8x4(p[8] * sc_, p[9] * sc_, p[10] * sc_, p[11] * sc_); o.w = pk_fp8x4(p[12] * sc_, p[13] * sc_, p[14] * sc_, p[15] * sc_);
            *(u32x4*)(W8 + (size_t)(n0 + nn) * K + k0 + 16 * c4) = o; }
        LDS_WAIT(); asm volatile("" ::: "memory"); return;
    }
    const int c = lane & 7; const bool perm2 = (kind == 2) && (nb % 3 == 2);
#pragma unroll
    for (int jj = 0; jj < 8; ++jj) { const int nn = (lane >> 3) + 8 * jj;
        int lcol = nn;
        if (perm2) lcol = (nn & 1) ? 32 + (nn >> 1) : (nn >> 1);
        if (kind == 3) { const int q = nn >> 3, w = nn & 7; lcol = w < 4 ? 4 * q + w : 32 + 4 * q + (w - 4); }
        const LAS float* p = scr + lcol * 65 + 8 * c;
        u32x4 o; o.x = cvt_pk(p[0], p[1]); o.y = cvt_pk(p[2], p[3]); o.z = cvt_pk(p[4], p[5]); o.w = cvt_pk(p[6], p[7]);
        *(u32x4*)(d.WT + (size_t)(n0 + nn) * K + k0 + 8 * c) = o; }
    LDS_WAIT(); asm volatile("" ::: "memory");
}
constexpr int IT_IN = (DM / 64) * (NP / 64), IT_KVB = (512 / 64) * (NKV / 64), IT_QB = ((ATT_FP8 ? 512 : 384) / 64) * (NQ / 64), IT_POOL1 = (256 / 64) * (512 / 64), IT_OUT = (DM / 64) * (DM / 64),
              IT_GU1 = (DM / 64) * (1024 / 64), IT_D1 = (512 / 64) * (DM / 64);
constexpr int ITO_KVB = IT_IN, ITO_QB = ITO_KVB + IT_KVB, ITO_POOL = ITO_QB + IT_QB, ITO_OUT = ITO_POOL + 4 * IT_POOL1, ITO_GU = ITO_OUT + IT_OUT, ITO_D = ITO_GU + 17 * IT_GU1, IT_LAYER = ITO_D + 17 * IT_D1;

__device__ __forceinline__ ItemDesc conv_desc(Frame& F, int it) {
    ItemDesc d; d.W2 = nullptr; d.fp8sh = -1; d.ksrc = 1 << 30;
    const int l = it / IT_LAYER; int r = it - l * IT_LAYER; char* wl = (char*)(F.ws() + WS_W + (size_t)l * LW_BYTES);
    if (r < ITO_KVB) { const int nb = r % (NP / 64);
        d.W = F.in(8) + (size_t)l * DM * IN_COLS; d.K = DM; d.srcN = IN_COLS; d.kind = 1; d.item = r; d.nblk = NP / 64;
        (void)nb; d.WT = (bf16*)(wl + LW_IN8); d.fp8sh = SH_WIN; }
    else if (r < ITO_QB) { d.W = F.in(12) + (size_t)l * 512 * NKV; d.K = 512; d.srcN = NKV; d.kind = 0; d.WT = (bf16*)(wl + LW_KVB); d.item = r - ITO_KVB; d.nblk = NKV / 64; if (ATT_FP8) d.fp8sh = SH_WKQ; }
    else if (r < ITO_POOL) { d.W = F.in(11) + (size_t)l * 384 * NQ; d.K = ATT_FP8 ? 512 : 384; d.srcN = NQ; d.kind = 2; d.WT = (bf16*)(wl + LW_QB); d.item = r - ITO_QB; d.nblk = NQ / 64; if (ATT_FP8) { d.fp8sh = SH_WKQ; d.ksrc = 384; } }
    else if (r < ITO_OUT) { r -= ITO_POOL; const int g = r / IT_POOL1; d.W = F.in(13) + (size_t)(l * 4 + g) * 256 * 512; d.K = 256; d.srcN = 512; d.kind = 0; d.WT = (bf16*)(wl + LW_POOL) + (size_t)g * 512 * 256; d.item = r - g * IT_POOL1; d.nblk = 512 / 64; }
    else if (r < ITO_GU) { d.W = F.in(15) + (size_t)l * DM * DM; d.K = DM; d.srcN = DM; d.kind = 0; d.WT = (bf16*)(wl + LW_OUT); d.item = r - ITO_OUT; d.nblk = DM / 64; if (ATT_FP8) d.fp8sh = SH_WOUT; }
    else if (r < ITO_D) { r -= ITO_GU; const int e = r / IT_GU1;
        d.W = e < 16 ? F.in(18) + (size_t)(l * 16 + e) * DM * 512 : F.in(21) + (size_t)l * DM * 512; d.W2 = e < 16 ? F.in(19) + (size_t)(l * 16 + e) * DM * 512 : F.in(22) + (size_t)l * DM * 512;
        d.K = DM; d.srcN = 512; d.kind = 3; d.WT = (bf16*)(wl + LW_GU + (size_t)e * 1024 * DM); d.item = r - e * IT_GU1; d.nblk = 1024 / 64; d.fp8sh = SH_WGU; }
    else { r -= ITO_D; const int e = r / IT_D1;
        d.W = e < 16 ? F.in(20) + (size_t)(l * 16 + e) * 512 * DM : F.in(23) + (size_t)l * 512 * DM;
        d.K = 512; d.srcN = DM; d.kind = 0; d.WT = (bf16*)(wl + LW_D + (size_t)e * DM * 512); d.item = r - e * IT_D1; d.nblk = DM / 64; d.fp8sh = SH_WD; }
    return d;
}
__device__ __forceinline__ void conv_pair(Frame& F, int itA, int itB, bool hasB) {
    LAS float* scr = (LAS float*)(F.lds + F.wave * 16640);
    const ItemDesc dA = conv_desc(F, itA), dB = conv_desc(F, hasB ? itB : itA);
    f32x4 va[16], vb[16];
    item_load(dA, F.lane, va); if (hasB) item_load(dB, F.lane, vb);
    item_finish(dA, F.lane, scr, va); if (hasB) item_finish(dB, F.lane, scr, vb);
}
__device__ __forceinline__ void conv_queue(Frame& F, unsigned* q, int lo, int hi) {
    for (;;) {
        int base = 0; if (F.lane == 0) base = (int)__hip_atomic_fetch_add(q, 4u, __ATOMIC_RELAXED, __HIP_MEMORY_SCOPE_AGENT);
        base = __builtin_amdgcn_readfirstlane(base) + lo; if (base >= hi) break;
        conv_pair(F, base, base + 1, base + 1 < hi); if (base + 2 < hi) conv_pair(F, base + 2, base + 3, base + 3 < hi);
    }
}
__device__ __forceinline__ void p0_prologue(Frame& F) {
    {
        LAS float* sil = (LAS float*)F.lds;
        LAS float* red = (LAS float*)(F.lds + 40960);
        for (int q = F.tid; q < 5 * DM; q += 512) { const int i = q / DM, k = q - i * DM; const float v = i < 4 ? F.in(1)[i * DM + k] : F.in(3)[k]; sil[q] = v * sigmoidf_(v); }
        __syncthreads();
        const int tx = F.tid & 31, ty = F.tid >> 5;
        for (int it = F.vcu; it < 2 * 96; it += F.G) {
            const int l = it / 96, c0 = (it - l * 96) * 128;
            const float* wp = F.in(4) + (size_t)l * DM * NMOD + c0 + 4 * tx;
            f32x4 a0 = {0, 0, 0, 0}, a1 = a0, a2 = a0, a3 = a0, a4 = a0;
#pragma unroll 8
            for (int r = ty; r < DM; r += 16) { const f32x4 w = *(const f32x4*)(wp + (size_t)r * NMOD);
                a0 += sil[r] * w; a1 += sil[DM + r] * w; a2 += sil[2 * DM + r] * w; a3 += sil[3 * DM + r] * w; a4 += sil[4 * DM + r] * w; }
            LAS f32x4* rp = (LAS f32x4*)red + (ty * 5) * 32 + tx;
            rp[0] = a0; rp[32] = a1; rp[64] = a2; rp[96] = a3; rp[128] = a4;
            __syncthreads();
            if (F.tid < 160) { const int i = F.tid >> 5; f32x4 s = *(const f32x4*)(F.in(5) + (size_t)l * NMOD + c0 + 4 * tx);
#pragma unroll
                for (int y = 0; y < 16; ++y) s += ((LAS f32x4*)red)[(y * 5 + i) * 32 + tx];
                *(f32x4*)(F.mod() + ((size_t)l * 5 + i) * NMOD + c0 + 4 * tx) = s; }
            __syncthreads();
        }
    }
    for (int q = F.vcu * 512 + F.tid; q < SEQ * 32; q += F.G * 512) { const int pos = q >> 5, i = q & 31;
        const float inv = __builtin_amdgcn_exp2f(-(float)(i & 15) * 0.830482023721841f);
        const float ang = (float)(i < 16 ? (pos >> 6) : (pos & 63)) * inv; const float rev = ang * 0.15915494309189535f; const float fr = rev - floorf(rev);
        F.cosT()[q] = __builtin_amdgcn_cosf(fr); F.sinT()[q] = __builtin_amdgcn_sinf(fr); }
    const int gw = F.vcu * NWAVES + F.wave, NGW = F.G * NWAVES;
    for (int it = gw; it < ITO_GU; it += 2 * NGW) conv_pair(F, it, it + NGW, it + NGW < ITO_GU);
}
__device__ __forceinline__ void t1_phase(Frame& F, int l) {
    const int gw = F.vcu * NWAVES + F.wave, NGW = F.G * NWAVES, lane = F.lane;
    const float* gn = F.in(6) + (size_t)l * DM;
    const int r_begin = (int)(((long)gw * T) / NGW), r_end = (int)(((long)(gw + 1) * T) / NGW);
    f32x4 cA[8], cB[8]; int cur = -1;
    for (int r0 = r_begin; r0 < r_end; r0 += 2) {
        f32x4 v[2][8];
#pragma unroll
        for (int u = 0; u < 2; ++u) { const int r = r0 + u;
            if (r < r_end) {
                if (l == 0) { const float* xr = xin_row(F, r);
#pragma unroll
                    for (int j = 0; j < 8; ++j) v[u][j] = *(const f32x4*)(xr + 256 * j + 4 * lane); }
                else { const bf16* xr = xres_row(F, r);
#pragma unroll
                    for (int j = 0; j < 8; ++j) v[u][j] = ld4bf(xr + 256 * j + 4 * lane); } } }
#pragma unroll
        for (int u = 0; u < 2; ++u) { const int r = r0 + u;
            if (r < r_end) { const int mr = mod_row(r);
                if (mr != cur) { cur = mr; const float* md = F.mod() + ((size_t)l * 5 + mr) * NMOD;
#pragma unroll
                    for (int j = 0; j < 8; ++j) { const int c = 256 * j + 4 * lane; cA[j] = *(const f32x4*)(gn + c) * (1.f + *(const f32x4*)(md + DM + c)); cB[j] = *(const f32x4*)(md + c); } }
                float ss = 0.f;
#pragma unroll
                for (int j = 0; j < 8; ++j) ss += (v[u][j][0] * v[u][j][0] + v[u][j][1] * v[u][j][1]) + (v[u][j][2] * v[u][j][2] + v[u][j][3] * v[u][j][3]);
                const float rinv = rsqrtf(wave_sum(ss) * (1.f / DM) + EPS);
                unsigned char* orow8 = (unsigned char*)F.Z() + (size_t)r * DM;
#pragma unroll
                for (int j = 0; j < 8; ++j) { const int c = 256 * j + 4 * lane;
                    const f32x4 y = (v[u][j] * rinv) * cA[j] + cB[j];
                    constexpr float S8 = (float)(1 << SH_H); *(unsigned*)(orow8 + c) = pk_fp8x4(y[0] * S8, y[1] * S8, y[2] * S8, y[3] * S8); } } }
    }
}
__device__ __forceinline__ void t2_phase(Frame& F, int l, bool dry) {
    const bool lastl = (l == DEPTH - 1);
    const int gw = F.vcu * NWAVES + F.wave, NGW = F.G * NWAVES, lane = F.lane;
    const float* gkv = F.in(10) + (size_t)l * 512; const float* gq = F.in(9) + (size_t)l * 384;
    const int r_begin = (int)(((long)gw * T) / NGW), r_end = (int)(((long)(gw + 1) * T) / NGW);
    for (int r = r_begin; r < r_end; ++r) {
        const int b = r / RPB, j = r - b * RPB; const bool isctx = j < CTX;
        bf16* prow = F.P() + (size_t)r * NP;
        {
            f32x4 v0, v1; pg8::unpack8(*(const u32x4*)(prow + lane * 8), v0, v1);
            float ss = (v0[0] * v0[0] + v0[1] * v0[1]) + (v0[2] * v0[2] + v0[3] * v0[3]) + (v1[0] * v1[0] + v1[1] * v1[1]) + (v1[2] * v1[2] + v1[3] * v1[3]);
            const float rinv = rsqrtf(wave_sum(ss) * (1.f / 512) + EPS);
            const f32x4 g0 = *(const f32x4*)(gkv + lane * 8), g1 = *(const f32x4*)(gkv + lane * 8 + 4);
#if ATT_FP8
            if (!dry) { const f32x4 a0 = v0 * rinv * g0 * (float)(1 << SH_LAT), a1 = v1 * rinv * g1 * (float)(1 << SH_LAT); u32x2 o; o.x = pk_fp8x4(a0[0], a0[1], a0[2], a0[3]); o.y = pk_fp8x4(a1[0], a1[1], a1[2], a1[3]);
                *(u32x2*)((unsigned char*)prow + lane * 8) = o; }
#else
            if (!dry) *(u32x4*)(prow + lane * 8) = pg8::pack8(v0 * rinv * g0, v1 * rinv * g1);
#endif
        }
        if (lane < 32) {
            float x1 = bf2f(prow[P_KPE + lane]), x2 = bf2f(prow[P_KPE + 32 + lane]);
            if (!isctx) { const int pos = j - CTX; const float cs = F.cosT()[pos * 32 + lane], sn = F.sinT()[pos * 32 + lane]; const float y1 = x1 * cs - x2 * sn, y2 = x2 * cs + x1 * sn; x1 = y1; x2 = y2; }
#if ATT_FP8
            { constexpr float SKp = (float)(1 << SH_K); const unsigned w = pk_fp8x4(x1 * SKp, x2 * SKp, 0.f, 0.f); ((unsigned short*)(F.KPE8() + (size_t)r * 64))[lane] = (unsigned short)w; }
#else
            ((unsigned*)(F.KPE() + (size_t)r * 64))[lane] = cvt_pk(x1, x2);
#endif
        }
        if (lastl && isctx) continue;
        {
            const bool act = lane < 48; f32x4 v0 = {0, 0, 0, 0}, v1 = v0;
            if (act) pg8::unpack8(*(const u32x4*)(prow + P_Q + lane * 8), v0, v1);
            float ss = (v0[0] * v0[0] + v0[1] * v0[1]) + (v0[2] * v0[2] + v0[3] * v0[3]) + (v1[0] * v1[0] + v1[1] * v1[1]) + (v1[2] * v1[2] + v1[3] * v1[3]);
            const float rinv = rsqrtf(wave_sum(ss) * (1.f / 384) + EPS);
#if ATT_FP8
            if (!dry) { u32x2 o; o.x = 0u; o.y = 0u;
                if (act) { const f32x4 g0 = *(const f32x4*)(gq + lane * 8), g1 = *(const f32x4*)(gq + lane * 8 + 4); const f32x4 a0 = v0 * rinv * g0 * (float)(1 << SH_LAT), a1 = v1 * rinv * g1 * (float)(1 << SH_LAT);
                    o.x = pk_fp8x4(a0[0], a0[1], a0[2], a0[3]); o.y = pk_fp8x4(a1[0], a1[1], a1[2], a1[3]); }
                *(u32x2*)((unsigned char*)prow + P_Q * 2 + lane * 8) = o; }
#else
            if (act && !dry) { const f32x4 g0 = *(const f32x4*)(gq + lane * 8), g1 = *(const f32x4*)(gq + lane * 8 + 4);
                *(u32x4*)(prow + P_Q + lane * 8) = pg8::pack8(v0 * rinv * g0, v1 * rinv * g1); }
#endif
        }
        {
            const int seg0 = b * RPB + (isctx ? 0 : CTX), n = isctx ? CTX : SEQ, t = isctx ? j : j - CTX;
            {
                const int ch = lane, g = ch >> 5, half = 1 << g; const bf16* pc = F.P() + (size_t)seg0 * NP + P_POOL + ch * 8;
                const int lo = t - half < 0 ? 0 : t - half, hi = t + half > n ? n : t + half;
                u32x4 w[4];
#pragma unroll
                for (int k = 0; k < 4; ++k) { int q = t - 2 + k; q = q < lo ? lo : (q >= hi ? hi - 1 : q); w[k] = *(const u32x4*)(pc + (size_t)q * NP); }
                f32x4 s0 = {0, 0, 0, 0}, s1 = s0, u0 = s0, u1 = s0;
#pragma unroll
                for (int k = 0; k < 4; ++k) { const int q = t - 2 + k; f32x4 a0, a1; pg8::unpack8(w[k], a0, a1); const float m = (q >= lo && q < hi) ? 1.f : 0.f; s0 += a0 * m; s1 += a1 * m; if (k == 2) { u0 = a0; u1 = a1; } }
                const float rc = 1.f / (float)(hi - lo);
                *(u32x4*)(F.Z() + (size_t)r * NZ + ch * 8) = pg8::pack8(s0 * rc - u0, s1 * rc - u1); }
            {
                const int ch = lane + 64, g = ch >> 5, half = 1 << g; const bf16* pc = F.P() + (size_t)seg0 * NP + P_POOL + ch * 8;
                const int lo = t - half < 0 ? 0 : t - half, hi = t + half > n ? n : t + half;
                u32x4 w[16];
#pragma unroll
                for (int k = 0; k < 16; ++k) { int q = t - 8 + k; q = q < lo ? lo : (q >= hi ? hi - 1 : q); w[k] = *(const u32x4*)(pc + (size_t)q * NP); }
                f32x4 s0 = {0, 0, 0, 0}, s1 = s0, u0 = s0, u1 = s0;
#pragma unroll
                for (int k = 0; k < 16; ++k) { const int q = t - 8 + k; f32x4 a0, a1; pg8::unpack8(w[k], a0, a1); const float m = (q >= lo && q < hi) ? 1.f : 0.f; s0 += a0 * m; s1 += a1 * m; if (k == 8) { u0 = a0; u1 = a1; } }
                const float rc = 1.f / (float)(hi - lo);
                *(u32x4*)(F.Z() + (size_t)r * NZ + ch * 8) = pg8::pack8(s0 * rc - u0, s1 * rc - u1); }
        }
    }
}
template <int CTRL> __device__ __forceinline__ float dpp_sel_add(float a, float b, bool hi) {
    const float keep = hi ? b : a, send = hi ? a : b; return keep + dppf<CTRL>(send);
}
__device__ __forceinline__ void t3_phase(Frame& F, int l, bool dry) {
    const bool lastl = (l == DEPTH - 1);
    LAS float* wrT = (LAS float*)F.lds;
    volatile LAS float* lgt = (volatile LAS float*)(F.ldsx + L_CIDX);
    volatile LAS int* rowid = (volatile LAS int*)(F.ldsx + L_CIDX + 80 * 64);
    volatile LAS int* pcnt = (volatile LAS int*)(F.ldsx + L_TAB);
    {
        f32x4 w4[16]; const f32x4* wsrc = (const f32x4*)F.in(16);
#pragma unroll
        for (int i = 0; i < 16; ++i) w4[i] = wsrc[F.tid + 512 * i];
#pragma unroll
        for (int i = 0; i < 16; ++i) { const int q4 = F.tid + 512 * i, k = q4 >> 2, e0 = (q4 & 3) * 4;
#pragma unroll
            for (int e = 0; e < 4; ++e) wrT[(e0 + e) * DM + k] = w4[i][e]; }
    }
    if (F.tid < 80) rowid[F.tid] = -1;
    if (F.tid < 64) pcnt[F.tid] = 0;
    __syncthreads();
    const int gw = F.vcu * NWAVES + F.wave, NGW = F.G * NWAVES, lane = F.lane;
    const float* gn = F.in(7) + (size_t)l * DM;
    const int nidx = lastl ? NBATCH * SEQ : T;
    const int i_begin = (int)(((long)gw * nidx) / NGW), i_end = (int)(((long)(gw + 1) * nidx) / NGW);
    f32x4 cA[8], cB[8]; int cur = -1;
    int it = 0;
    for (int i0 = i_begin; i0 < i_end; i0 += 2, ++it) {
        int rr[2]; bool ok[2]; f32x4 v[2][8];
#pragma unroll
        for (int u = 0; u < 2; ++u) { int idx = i0 + u; ok[u] = idx < i_end; if (!ok[u]) idx = i0; rr[u] = lastl ? (idx >> 12) * RPB + CTX + (idx & 4095) : idx;
            const bf16* xr = xres_row(F, rr[u]);
#pragma unroll
            for (int jj = 0; jj < 8; ++jj) v[u][jj] = ld4bf(xr + 256 * jj + 4 * lane); }
#pragma unroll
        for (int u = 0; u < 2; ++u) { const int r = rr[u]; float ss = 0.f; const int mr = mod_row(r);
            if (mr != cur) { cur = mr; const float* md = F.mod() + ((size_t)l * 5 + mr) * NMOD + 3 * DM;
#pragma unroll
                for (int jj = 0; jj < 8; ++jj) { const int c = 256 * jj + 4 * lane; cA[jj] = *(const f32x4*)(gn + c) * (1.f + *(const f32x4*)(md + DM + c)); cB[jj] = *(const f32x4*)(md + c); } }
#pragma unroll
            for (int jj = 0; jj < 8; ++jj) ss += (v[u][jj][0] * v[u][jj][0] + v[u][jj][1] * v[u][jj][1]) + (v[u][jj][2] * v[u][jj][2] + v[u][jj][3] * v[u][jj][3]);
            const float rinv = rsqrtf(wave_sum(ss) * (1.f / DM) + EPS);
            unsigned char* orow = (unsigned char*)F.HM() + (size_t)r * DM;
#pragma unroll
            for (int jj = 0; jj < 8; ++jj) { const int c = 256 * jj + 4 * lane;
                v[u][jj] = (v[u][jj] * rinv) * cA[jj] + cB[jj]; constexpr float S2 = (float)(1 << SH_H2);
                if (ok[u]) *(unsigned*)(orow + c) = pk_fp8x4(v[u][jj][0] * S2, v[u][jj][1] * S2, v[u][jj][2] * S2, v[u][jj][3] * S2); } }
        float s[32];
#pragma unroll
        for (int e = 0; e < 16; ++e) { float s0 = 0.f, s1 = 0.f;
#pragma unroll
            for (int jj = 0; jj < 8; ++jj) { const f32x4 w = *(const LAS f32x4*)(wrT + e * DM + 256 * jj + 4 * lane);
                s0 += (v[0][jj][0] * w[0] + v[0][jj][1] * w[1]) + (v[0][jj][2] * w[2] + v[0][jj][3] * w[3]); s1 += (v[1][jj][0] * w[0] + v[1][jj][1] * w[1]) + (v[1][jj][2] * w[2] + v[1][jj][3] * w[3]); }
            s[e] = s0; s[16 + e] = s1; }
#pragma unroll
        for (int i = 0; i < 16; ++i) { auto q = __builtin_amdgcn_permlane32_swap(__float_as_uint(s[i]), __float_as_uint(s[i + 16]), false, false); s[i] = __uint_as_float(q[0]) + __uint_as_float(q[1]); }
#pragma unroll
        for (int i = 0; i < 8; ++i) { auto q = __builtin_amdgcn_permlane16_swap(__float_as_uint(s[i]), __float_as_uint(s[i + 8]), false, false); s[i] = __uint_as_float(q[0]) + __uint_as_float(q[1]); }
#pragma unroll
        for (int i = 0; i < 4; ++i) s[i] = dpp_sel_add<0x128>(s[i], s[i + 4], (lane & 8) != 0);
#pragma unroll
        for (int i = 0; i < 2; ++i) s[i] = dpp_sel_add<0x141>(s[i], s[i + 2], (lane & 4) != 0);
        s[0] = dpp_sel_add<0x4E>(s[0], s[1], (lane & 2) != 0);
        s[0] += dppf<0xB1>(s[0]);
        const int u = lane >> 5, slot = (F.wave * 5 + it) * 2 + u;
        if ((lane & 1) == 0) lgt[slot * 16 + ((lane >> 1) & 15)] = s[0];
        if ((lane & 31) == 0 && (u == 0 ? ok[0] : ok[1])) rowid[slot] = u == 0 ? rr[0] : rr[1];
    }
    __syncthreads();
    int pair = -1, rank = 0, myrow = -1; float wa = 0.f, wb = 0.f;
    if (F.tid < 80 && !dry) { myrow = rowid[F.tid];
      if (myrow >= 0) {
        float sc_[16], sel[16];
#pragma unroll
        for (int e = 0; e < 16; ++e) { sc_[e] = 1.f / (1.f + expf(-lgt[F.tid * 16 + e])); sel[e] = sc_[e] + F.in(17)[e]; }
        int bg = 0; float bgs = -1e30f;
#pragma unroll
        for (int g = 0; g < 4; ++g) { float m1 = -1e30f, m2 = -1e30f;
#pragma unroll
            for (int k = 0; k < 4; ++k) { const float x = sel[4 * g + k]; if (x > m1) { m2 = m1; m1 = x; } else if (x > m2) m2 = x; }
            const float gs = m1 + m2; if (gs > bgs) { bgs = gs; bg = g; } }
        float s4[4], q4[4];
#pragma unroll
        for (int k = 0; k < 4; ++k) { s4[k] = bg == 0 ? sel[k] : (bg == 1 ? sel[4 + k] : (bg == 2 ? sel[8 + k] : sel[12 + k])); q4[k] = bg == 0 ? sc_[k] : (bg == 1 ? sc_[4 + k] : (bg == 2 ? sc_[8 + k] : sc_[12 + k])); }
        int i1 = 0; float m1 = s4[0];
#pragma unroll
        for (int k = 1; k < 4; ++k) if (s4[k] > m1) { m1 = s4[k]; i1 = k; }
        int i2 = -1; float m2 = -1e30f;
#pragma unroll
        for (int k = 0; k < 4; ++k) if (k != i1 && s4[k] > m2) { m2 = s4[k]; i2 = k; }
        const float w1 = i1 == 0 ? q4[0] : (i1 == 1 ? q4[1] : (i1 == 2 ? q4[2] : q4[3])), w2 = i2 == 0 ? q4[0] : (i2 == 1 ? q4[1] : (i2 == 2 ? q4[2] : q4[3]));
        const float ws_ = 1.f / (w1 + w2);
        const int a = i1 < i2 ? i1 : i2, bb = i1 < i2 ? i2 : i1; wa = (i1 < i2 ? w1 : w2) * ws_; wb = (i1 < i2 ? w2 : w1) * ws_;
        const int pidx = a == 0 ? bb - 1 : (a == 1 ? bb + 1 : 5); pair = bg * 6 + pidx;
        rank = __hip_atomic_fetch_add((LAS int*)(pcnt + pair), 1, __ATOMIC_RELAXED, __HIP_MEMORY_SCOPE_WORKGROUP);
      } }
    __syncthreads();
    if (F.tid < NPAIR) { const int c = pcnt[F.tid];
        pcnt[32 + F.tid] = c ? (int)__hip_atomic_fetch_add(F.ctl() + CW_CNT + (l * NPAIR + F.tid) * 64, (unsigned)c, __ATOMIC_RELAXED, __HIP_MEMORY_SCOPE_AGENT) : 0; }
    __syncthreads();
    if (pair >= 0) { const size_t dst = (size_t)pair * T + pcnt[32 + pair] + rank; F.ltok()[dst] = myrow; F.lwa()[dst] = wa; F.lwb()[dst] = wb; }
    __syncthreads();
}
__device__ __forceinline__ void moe_setup(Frame& F, int l, int nN) {
    volatile LAS int* tab = (volatile LAS int*)(F.ldsx + L_TAB);
    volatile LAS int* cidx = (volatile LAS int*)(F.ldsx + L_CIDX); volatile LAS float* cwa = (volatile LAS float*)(F.ldsx + L_CWA); volatile LAS float* cwb = (volatile LAS float*)(F.ldsx + L_CWB);
    __syncthreads();
    if (F.tid < NPAIR) tab[F.tid] = (int)__hip_atomic_load(F.ctl() + CW_CNT + (l * NPAIR + F.tid) * 64, __ATOMIC_RELAXED, __HIP_MEMORY_SCOPE_AGENT);
    __syncthreads();
    if (F.tid == 0) { int s = 0; for (int p = 0; p < NPAIR; ++p) { tab[24 + p] = s; s += (tab[p] + 255) >> 8; } tab[24 + NPAIR] = s; }
    __syncthreads();
    const int total = tab[24 + NPAIR] * nN;
    {
        int tok[4]; float wa[4], wb[4];
#pragma unroll
        for (int k4 = 0; k4 < 4; ++k4) { const int q = F.tid + 512 * k4, i = q >> 8, row = q & 255; const int L = i * F.G + F.bx; tok[k4] = 0; wa[k4] = 0.f; wb[k4] = 0.f;
            if (L < total) { const int mt = L / nN; int p = 0; for (int k = 1; k < NPAIR; ++k) if (tab[24 + k] <= mt) p = k;
                const int lr = (mt - tab[24 + p]) * 256 + row; if (lr < tab[p]) { const size_t s = (size_t)p * T + lr; tok[k4] = F.ltok()[s]; wa[k4] = F.lwa()[s]; wb[k4] = F.lwb()[s]; } } }
#pragma unroll
        for (int k4 = 0; k4 < 4; ++k4) { const int q = F.tid + 512 * k4; cidx[q] = tok[k4]; cwa[q] = wa[k4]; cwb[q] = wb[k4]; } }
    __syncthreads();
}
__device__ __forceinline__ void final_phase(Frame& F) {
    const int gw = F.vcu * NWAVES + F.wave, NGW = F.G * NWAVES, lane = F.lane; const float* gn = F.in(24);
    const int r_begin = (int)(((long)gw * (NBATCH * SEQ)) / NGW), r_end = (int)(((long)(gw + 1) * (NBATCH * SEQ)) / NGW);
    f32x4 g[8];
#pragma unroll
    for (int j = 0; j < 8; ++j) g[j] = *(const f32x4*)(gn + 256 * j + 4 * lane);
    for (int r0 = r_begin; r0 < r_end; r0 += 2) {
        f32x4 v[2][8];
#pragma unroll
        for (int u = 0; u < 2; ++u) { const int r = r0 + u;
            if (r < r_end) { const bf16* xr = xres_row(F, (r >> 12) * RPB + CTX + (r & 4095));
#pragma unroll
                for (int j = 0; j < 8; ++j) v[u][j] = ld4bf(xr + 256 * j + 4 * lane); } }
#pragma unroll
        for (int u = 0; u < 2; ++u) { const int r = r0 + u;
            if (r < r_end) { float* xr = F.out() + (size_t)r * DM; float ss = 0.f;
#pragma unroll
                for (int j = 0; j < 8; ++j) ss += (v[u][j][0] * v[u][j][0] + v[u][j][1] * v[u][j][1]) + (v[u][j][2] * v[u][j][2] + v[u][j][3] * v[u][j][3]);
                const float rinv = rsqrtf(wave_sum(ss) * (1.f / DM) + EPS);
#pragma unroll
                for (int j = 0; j < 8; ++j) { const int c = 256 * j + 4 * lane; *(f32x4*)(xr + c) = v[u][j] * rinv * g[j]; } } }
    }
}

constexpr int CW_BAD = 12416;
#if PROBE_ATTN
__device__ __forceinline__ void attn_check(Frame& F, int l) {
    LAS float* qv = (LAS float*)F.lds;
    LAS float* sc = qv + 256;
    LAS float* red = sc + 4352;
    const bf16* dbg = (const bf16*)(F.ws() + WS_END);
    for (int s = F.bx; s < 384; s += F.G) {
        const int u = s / 6, kind = (s / 3) & 1, ri = s % 3, rloc = ri == 0 ? 0 : (ri == 1 ? 100 : 255), b = u >> 4, h = u & 15;
        const int qrow = kind == 0 ? b * RPB + CTX + 3 * 256 + rloc : b * RPB + rloc, seq = kind == 0 ? RPB : CTX;
        __syncthreads();
#if ATT_FP8
        if (F.tid < 128) { const size_t qi = (size_t)qrow * NQ + h * 192 + F.tid; qv[F.tid] = __builtin_amdgcn_cvt_f32_fp8((int)F.Q8()[qi], 0) * (1.f / (QK_C * (float)(1 << SH_QC))); }
#else
        if (F.tid < 128) qv[F.tid] = bf2f(F.Q()[(size_t)qrow * NQ + h * 192 + F.tid]);
#endif
        if (F.tid >= 128 && F.tid < 192) { const int i = F.tid - 128; float a = 0.f;
#if ATT_FP8
            for (int k = 0; k < 384; ++k) a += __builtin_amdgcn_cvt_f32_fp8((int)((const unsigned char*)(F.P() + (size_t)qrow * NP))[P_Q * 2 + k], 0) * (1.f / (float)(1 << SH_LAT)) * F.in(11)[((size_t)l * 384 + k) * NQ + h * 192 + 128 + i];
#else
            for (int k = 0; k < 384; ++k) a += bf2f(F.P()[(size_t)qrow * NP + P_Q + k]) * F.in(11)[((size_t)l * 384 + k) * NQ + h * 192 + 128 + i];
#endif
            qv[128 + i] = a; }
        __syncthreads();
        if (kind == 0 && F.tid < 32) { const int i = F.tid, pos = qrow - b * RPB - CTX; const float inv = __builtin_amdgcn_exp2f(-(float)(i & 15) * 0.830482023721841f), ang = (float)(i < 16 ? pos / 64 : pos % 64) * inv;
            const float c = __cosf(ang), sn = __sinf(ang), x1 = qv[128 + i], x2 = qv[160 + i]; qv[128 + i] = x1 * c - x2 * sn; qv[160 + i] = x2 * c + x1 * sn; }
        __syncthreads();
        float mx = -1e30f;
        for (int j = F.tid; j < seq; j += 512) { const size_t kr = (size_t)b * RPB + j; float a = 0.f;
#if ATT_FP8
            for (int d = 0; d < 128; ++d) a += qv[d] * __builtin_amdgcn_cvt_f32_fp8((int)F.K8()[kr * DM + h * 128 + d], 0) * (1.f / (float)(1 << SH_K));
#else
            for (int d = 0; d < 128; ++d) a += qv[d] * bf2f(F.KV()[kr * NKV + h * 256 + d]);
#endif
            for (int i = 0; i < 32; ++i) { float x1 = bf2f(F.P()[kr * NP + P_KPE + i]), x2 = bf2f(F.P()[kr * NP + P_KPE + 32 + i]);
                if (j >= CTX) { const int pos = j - CTX; const float inv = __builtin_amdgcn_exp2f(-(float)(i & 15) * 0.830482023721841f), ang = (float)(i < 16 ? pos / 64 : pos % 64) * inv; const float c = __cosf(ang), sn = __sinf(ang);
                    const float y1 = x1 * c - x2 * sn, y2 = x2 * c + x1 * sn; x1 = y1; x2 = y2; }
                a += qv[128 + i] * x1 + qv[160 + i] * x2; }
            a *= 0.07216878364870322f; sc[j] = a; mx = fmaxf(mx, a); }
        red[F.tid] = mx; __syncthreads();
        if (F.tid == 0) { float m = -1e30f; for (int k = 0; k < 512; ++k) m = fmaxf(m, red[k]); red[0] = m; } __syncthreads();
        mx = red[0]; __syncthreads();
        float sm = 0.f; for (int j = F.tid; j < seq; j += 512) { const float p = __builtin_amdgcn_exp2f((sc[j] - mx) * 1.4426950408889634f); sc[j] = p; sm += p; }
        red[F.tid] = sm; __syncthreads();
        if (F.tid == 0) { float t = 0.f; for (int k = 0; k < 512; ++k) t += red[k]; red[0] = t; } __syncthreads();
        sm = red[0]; __syncthreads();
        float e2 = 0.f, o2 = 0.f;
#if ATT_FP8
        if (F.tid < 128) { float o = 0.f;
            for (int j = 0; j < seq; ++j) { const int kk = j & 63, c = kk & 31, slot = (j & ~63) + 32 * ((c >> 2) & 1) + 16 * (kk >> 5) + (c & 3) + 4 * (c >> 3);
                o += sc[j] * __builtin_amdgcn_cvt_f32_fp8((int)F.VT8()[((size_t)(b * NH + h) * 128 + F.tid) * RPB + slot], 0) * (1.f / (float)(1 << SH_V)); }
#else
        if (F.tid < 128) { float o = 0.f; for (int j = 0; j < seq; ++j) o += sc[j] * bf2f(F.KV()[((size_t)b * RPB + j) * NKV + h * 256 + 128 + F.tid]);
#endif
            o /= sm; const float got = bf2f(dbg[((size_t)(u * 2 + kind) * 256 + rloc) * 128 + F.tid]); e2 = (o - got) * (o - got); o2 = o * o; }
        red[F.tid] = e2; __syncthreads();
        float esum = 0.f; if (F.tid == 0) { for (int k = 0; k < 128; ++k) esum += red[k]; } __syncthreads();
        red[F.tid] = o2; __syncthreads();
        if (F.tid == 0) { float t = 0.f; for (int k = 0; k < 128; ++k) t += red[k]; if (!(esum <= 1.6e-3f * t)) __hip_atomic_fetch_add(F.ctl() + CW_BAD, 1u, __ATOMIC_RELAXED, __HIP_MEMORY_SCOPE_AGENT); }
        __syncthreads();
    }
}
#endif
constexpr int NPHASE = 20;
__global__ void __launch_bounds__(NWAVES * 64, 2) fwd(Args args) {
    extern __shared__ __attribute__((aligned(16))) unsigned char lds[];
    Frame F; F.lds = (LAS unsigned char*)lds; F.wave = __builtin_amdgcn_readfirstlane((int)threadIdx.x >> 6); F.fresh();
    volatile LAS unsigned* MISC = (volatile LAS unsigned*)(F.lds + L_MISC);
    if (F.tid < 128) MISC[F.tid] = 0u;
    __syncthreads();
    const int lo = args.ph_lo, hi = args.ph_hi;
    const bool multi = (hi - lo) > 1;
    if (multi) (void)xcd_barrier_post(F.ctl() + CW_BAR, MISC + 8, F.tid == 0);
#ifndef ONLY_PH
#define ONLY_PH -1
#endif
#define SEL(kind) (ONLY_PH < 0 || ONLY_PH == (kind))
#ifndef PROBE_DUP
#define PROBE_DUP -1
#endif
#define DUP(kind) (PROBE_DUP == (kind))
#define IN(k) (lo <= (k) && (k) < hi)
#define SEAM(k) do { if (IN(k) && IN((k) + 1)) { F.fresh(); XcdBarrier b_; b_.bar = F.ctl() + CW_BAR; b_.x = xb_xcc_id(); b_.st = MISC + 8; xcd_barrier(b_, F.tid == 0); if (DUP(99)) xcd_barrier(b_, F.tid == 0); } } while (0)

    if (SEL(0) && IN(0)) { F.fresh(); p0_prologue(F); __syncthreads(); if (DUP(0)) { p0_prologue(F); __syncthreads(); } SEAM(0); }

    for (int l = 0; l < DEPTH; ++l) {
        const int pb = 1 + 9 * l; const bool lastl = (l == DEPTH - 1);
#define WL (F.ws() + WS_W + (size_t)l * LW_BYTES)
#define MODL (F.mod() + (size_t)l * 5 * NMOD)
        if (SEL(1) && IN(pb + 0)) { F.fresh(); t1_phase(F, l); if (DUP(1)) t1_phase(F, l); SEAM(pb + 0); }
        if (SEL(2) && IN(pb + 1)) { F.fresh();
            pg8::EpiP E{F.P()};
            { pg8::A8Sched S{(const unsigned char*)F.Z(), (const unsigned char*)(WL + LW_IN8), F.G, F.bx};
              pg8::gemm_phase<pg8::EpiP, pg8::A8Sched, true>(F.lds, F.wave, S, E); if (DUP(2) || DUP(22)) pg8::gemm_phase<pg8::EpiP, pg8::A8Sched, true>(F.lds, F.wave, S, E);
              if (DUP(23)) { pg8::EpiNull E0{F.mod()}; pg8::gemm_phase<pg8::EpiNull, pg8::A8Sched, true>(F.lds, F.wave, S, E0); } }
            if (l == 0) conv_queue(F, F.ctl() + CW_Q1, ITO_GU, IT_LAYER);
            if (DUP(97) && l == 0) conv_queue(F, F.ctl() + CW_Q1 + 128, ITO_GU, IT_LAYER);
            SEAM(pb + 1);
        }
        if (SEL(3) && IN(pb + 2)) { F.fresh(); if (DUP(3)) t2_phase(F, l, F.G != 12345); t2_phase(F, l, false); SEAM(pb + 2); }
        if (SEL(4) && IN(pb + 3)) { F.fresh();
#if ATT_FP8
            { pg8::KQ8Sched S{F.ws(), WS_W + (size_t)l * LW_BYTES, F.G, F.bx, lastl ? 64 : T / 256, lastl};
              pg8::EpiKQ8 E{{F.K8(), F.VT8()}, {F.Q8(), F.cosT(), F.sinT()}};
              pg8::gemm_phase<pg8::EpiKQ8, pg8::KQ8Sched, true>(F.lds, F.wave, S, E); if (DUP(4) || DUP(44)) pg8::gemm_phase<pg8::EpiKQ8, pg8::KQ8Sched, true>(F.lds, F.wave, S, E); }
            { pg8::DenseSched S{F.Z(), (const bf16*)(WL + LW_POOL), NZ, 256, lastl ? 64 : T / 256, DM / 256, F.G, (F.bx + F.G / 2) % F.G, 1, 256, lastl, 256, 0};
              pg8::EpiPool E{F.HM(), F.P(), F.in(14) + (size_t)l * DM};
              pg8::gemm_phase<pg8::EpiPool, pg8::DenseSched, true>(F.lds, F.wave, S, E); if (DUP(4) || DUP(45)) pg8::gemm_phase<pg8::EpiPool, pg8::DenseSched, true>(F.lds, F.wave, S, E); }
#else
            pg8::TriSched S{F.ws(), WS_W + (size_t)l * LW_BYTES, F.G, F.bx, lastl ? 64 : T / 256, lastl};
            pg8::EpiTri E{{F.KV(), NKV}, {F.Q(), F.cosT(), F.sinT()}, {F.HM(), F.P(), F.in(14) + (size_t)l * DM}};
            pg8::gemm_phase<pg8::EpiTri, pg8::TriSched, true>(F.lds, F.wave, S, E);
            if (DUP(4)) pg8::gemm_phase<pg8::EpiTri, pg8::TriSched, true>(F.lds, F.wave, S, E);
#endif
            SEAM(pb + 3);
        }
        if (SEL(5) && IN(pb + 4)) { F.fresh();
            const int nunits = NBATCH * NH * 16 + (l == 0 ? NBATCH * NH : 0);
            for (int rep = DUP(5) ? 0 : 1; rep < 2; ++rep)
            for (int i = 0;; ++i) { const int L = i * F.G + F.vcu; if (L >= nunits) break;
                int b, h, q0, seq;
                if (L < NBATCH * NH * 16) { const int bh = L >> 4, qb = L & 15; b = bh >> 4; h = bh & 15; q0 = b * RPB + CTX + qb * 256; seq = RPB; }
                else { const int bh = L - NBATCH * NH * 16; b = bh >> 4; h = bh & 15; q0 = b * RPB; seq = CTX; }
                const size_t k0 = (size_t)b * RPB;
#if PROBE_ATTN
                __syncthreads();
                if (F.tid == 0) *(bf16* volatile*)((char*)lds + L_MISC + 64) = (L >= NBATCH * NH * 16) ? (bf16*)(F.ws() + WS_END) + ((size_t)((b * 16 + h) * 2 + 1) * 256) * 128
                                                                               : (((L & 15) == 3) ? (bf16*)(F.ws() + WS_END) + ((size_t)((b * 16 + h) * 2 + 0) * 256) * 128 : (bf16*)nullptr);
#endif
#if ATT_FP8
                att8::attn_unit(F.Q8() + (size_t)q0 * NQ + h * 192, F.K8() + k0 * DM + h * 128, F.KPE8() + k0 * 64, F.VT8() + (size_t)(b * NH + h) * 128 * RPB,
                                F.HM() + (size_t)q0 * DM + h * 128, F.P() + (size_t)q0 * NP + P_GM + h * 128, F.M8() + (size_t)q0 * DM + h * 128, seq, (char*)lds, rep == 0, F.wave); }
#else
                att::attn_unit(F.Q() + (size_t)q0 * NQ + h * 192, F.KV() + k0 * NKV + h * 256, F.KV() + k0 * NKV + h * 256 + 128, F.KPE() + k0 * 64,
                               F.HM() + (size_t)q0 * DM + h * 128, F.P() + (size_t)q0 * NP + P_GM + h * 128, seq, (char*)lds, rep == 0, F.wave); }
#endif
            __syncthreads();
            SEAM(pb + 4);
        }
        if (SEL(6) && IN(pb + 5)) { F.fresh();
#if PROBE_ATTN
            if (l == 0) { attn_check(F, l); __syncthreads(); }
#endif
            pg8::EpiRes E{&F, l == 0, MODL + 2 * DM};
#if ATT_FP8
            pg8::D8Sched S{F.M8(), (const unsigned char*)(WL + LW_OUT), F.G, F.bx, lastl ? 64 : T / 256, lastl};
            pg8::gemm_phase<pg8::EpiRes, pg8::D8Sched, true>(F.lds, F.wave, S, E);
            if (DUP(6) && l == 0) pg8::gemm_phase<pg8::EpiRes, pg8::D8Sched, true>(F.lds, F.wave, S, E);
#else
            pg8::DenseSched S{F.HM(), (const bf16*)(WL + LW_OUT), DM, DM, lastl ? 64 : T / 256, DM / 256, F.G, F.bx, 0, 0, lastl, DM, 0};
            pg8::gemm_phase<pg8::EpiRes, pg8::DenseSched, true>(F.lds, F.wave, S, E);
            if (DUP(6) && l == 0) pg8::gemm_phase<pg8::EpiRes, pg8::DenseSched, true>(F.lds, F.wave, S, E);
#endif
            if (l == 0) conv_queue(F, F.ctl() + CW_Q2, IT_LAYER, 2 * IT_LAYER);
            if (DUP(97) && l == 0) conv_queue(F, F.ctl() + CW_Q2 + 128, IT_LAYER, 2 * IT_LAYER);
            SEAM(pb + 5);
        }
        if (SEL(7) && IN(pb + 6)) { F.fresh(); if (DUP(7)) t3_phase(F, l, F.G != 12345); t3_phase(F, l, false); SEAM(pb + 6); }
        if (SEL(8) && IN(pb + 7)) { F.fresh();
            moe_setup(F, l, 12);
            pg8::MoeUpSched S{(const unsigned char*)F.HM(), (const unsigned char*)(WL + LW_GU), F.G, F.bx, (const volatile LAS int*)(F.ldsx + L_TAB), (const volatile LAS int*)(F.ldsx + L_CIDX)};
            pg8::EpiUp E{(unsigned char*)F.ACT(), (const volatile LAS float*)(F.ldsx + L_CWA), (const volatile LAS float*)(F.ldsx + L_CWB)};
            pg8::gemm_phase<pg8::EpiUp, pg8::MoeUpSched, true>(F.lds, F.wave, S, E);
            if (DUP(8)) pg8::gemm_phase<pg8::EpiUp, pg8::MoeUpSched, true>(F.lds, F.wave, S, E);
            SEAM(pb + 7);
        }
        if (SEL(9) && IN(pb + 8)) { F.fresh();
            moe_setup(F, l, 8);
            pg8::MoeDownSched S{(const unsigned char*)F.ACT(), (const unsigned char*)(WL + LW_D), F.G, F.bx, (const volatile LAS int*)(F.ldsx + L_TAB)};
            if (DUP(9)) { pg8::EpiDown E0{&F, MODL + 5 * DM, (const volatile LAS int*)(F.ldsx + L_CIDX), F.G != 12345};
                pg8::gemm_phase<pg8::EpiDown, pg8::MoeDownSched, true>(F.lds, F.wave, S, E0); }
            pg8::EpiDown E{&F, MODL + 5 * DM, (const volatile LAS int*)(F.ldsx + L_CIDX), false};
            pg8::gemm_phase<pg8::EpiDown, pg8::MoeDownSched, true>(F.lds, F.wave, S, E);
            SEAM(pb + 8);
        }
    }
    if (SEL(10) && IN(19)) { F.fresh(); final_phase(F);
#if PROBE_ATTN
        if (__hip_atomic_load(F.ctl() + CW_BAD, __ATOMIC_RELAXED, __HIP_MEMORY_SCOPE_AGENT) != 0u && F.tid == 0) F.out()[F.bx] = __builtin_nanf("");
#endif
    }
#undef IN
#undef SEAM
}

extern "C" void kernel_launch(void* const* d_in, const int* in_sizes, int n_in, void* d_out, int out_size, void* d_ws, size_t ws_size, hipStream_t stream) {
    static int grid = 0;
    if (grid == 0) {
        if (n_in != 25 || out_size != NBATCH * SEQ * DM || ws_size < WS_END) { fprintf(stderr, "kernel_launch: unexpected shapes (n_in %d out %d ws %zu)\n", n_in, out_size, ws_size); grid = -1; return; }
        int dev = 0, cus = 0;
        if (hipGetDevice(&dev) != hipSuccess || hipDeviceGetAttribute(&cus, hipDeviceAttributeMultiprocessorCount, dev) != hipSuccess) { grid = -1; return; }
        if (hipFuncSetAttribute((const void*)fwd, hipFuncAttributeMaxDynamicSharedMemorySize, LDS_BYTES) != hipSuccess) { fprintf(stderr, "kernel_launch: hipFuncSetAttribute failed\n"); grid = -1; return; }
        int per_cu = 0;
        if (hipOccupancyMaxActiveBlocksPerMultiprocessor(&per_cu, (const void*)fwd, NWAVES * 64, LDS_BYTES) != hipSuccess || per_cu < 1) { fprintf(stderr, "kernel_launch: occupancy query says %d\n", per_cu); }
        (void)hipGetLastError();
        grid = cus;
    }
    if (grid < 0) return;
    (void)hipMemsetAsync((char*)d_ws + WS_CTL, 0, CTL_ZERO_BYTES, stream);
    Args a{};
    for (int i = 0; i < 25; ++i) a.in[i] = (const float*)d_in[i];
    a.out = (float*)d_out; a.ws = (unsigned char*)d_ws;
#if MK_PER_PHASE
    for (int k = 0; k < NPHASE; ++k) { a.ph_lo = k; a.ph_hi = k + 1; hipLaunchKernelGGL(fwd, dim3(grid), dim3(NWAVES * 64), LDS_BYTES, stream, a); }
#else
    a.ph_lo = 0; a.ph_hi = NPHASE; hipLaunchKernelGGL(fwd, dim3(grid), dim3(NWAVES * 64), LDS_BYTES, stream, a);
#endif
}
```

```cpp
#include <hip/hip_runtime.h>
#include <cstdio>
#include <cstdint>

#ifndef PROBE_ATTN
#define PROBE_ATTN 0
#endif
#ifndef ATT_FP8
#define ATT_FP8 1
#endif
#ifndef MK_PER_PHASE
#define MK_PER_PHASE 0
#endif

#define LAS __attribute__((address_space(3)))
#define GAS __attribute__((address_space(1)))
typedef unsigned short bf16;
typedef short bf16x8 __attribute__((ext_vector_type(8)));
typedef short s16x4 __attribute__((ext_vector_type(4)));
typedef float f32x2 __attribute__((ext_vector_type(2)));
typedef float f32x4 __attribute__((ext_vector_type(4)));
typedef float f32x16 __attribute__((ext_vector_type(16)));
typedef unsigned u32x2 __attribute__((ext_vector_type(2)));
typedef unsigned u32x4 __attribute__((ext_vector_type(4)));
typedef int i32x4 __attribute__((ext_vector_type(4)));
typedef int i32x8 __attribute__((ext_vector_type(8)));

constexpr int DM = 2048, NBATCH = 4, SEQ = 4096, CTX = 256, RPB = SEQ + CTX, T = NBATCH * RPB, NH = 16, DEPTH = 2;
constexpr int IN_COLS = 6080, NP = 6144, NKV = 4096, NQ = 3072, NZ = 1024, NACT = 1536;
constexpr int P_Q = 512, P_KPE = 896, P_POOL = 1024, P_GM = 2048, P_GP = 4096;
constexpr int NPAIR = 24, NMOD = 6 * DM;
constexpr float EPS = 1e-6f;
constexpr int NWAVES = 8;

constexpr size_t MiB = 1u << 20;
constexpr size_t WS_CTL = 0, CTL_ZERO_BYTES = 1 * MiB;
constexpr size_t WS_LTOK = 4 * MiB, WS_LWA = 6 * MiB, WS_LWB = 8 * MiB;
constexpr size_t WS_MOD = 10 * MiB;
constexpr size_t WS_COS = 11 * MiB, WS_SIN = 12 * MiB;
constexpr size_t WS_W = 16 * MiB;
constexpr size_t LW_IN = 0, LW_IN8 = (size_t)2048 * DM * 2  , LW_KVB = LW_IN + (size_t)NP * DM * 2, LW_QB = LW_KVB + (size_t)NKV * 512 * 2, LW_POOL = LW_QB + (size_t)NQ * 384 * 2,
                 LW_OUT = LW_POOL + (size_t)4 * 512 * 256 * 2, LW_GU = LW_OUT + (size_t)DM * DM * 2, LW_D = LW_GU + (size_t)17 * 1024 * DM  ,
                 LW_BYTES = LW_D + (size_t)17 * DM * 512  ;
constexpr size_t WS_XCTX = 300 * MiB;
constexpr size_t WS_P = 308 * MiB;
constexpr size_t WS_Z = 512 * MiB;
constexpr size_t WS_KPE = 546 * MiB;
constexpr size_t WS_KV = 549 * MiB;
constexpr size_t WS_Q = 685 * MiB;
constexpr size_t WS_XB = WS_KV + 68 * MiB;
constexpr size_t WS_HM = 787 * MiB;
constexpr size_t WS_END = 855 * MiB;
static_assert(WS_W + 2 * LW_BYTES <= WS_XCTX, "weights fit");
static_assert(WS_XB + (size_t)T * DM * 2 <= WS_Q && (size_t)T * DM == 34 * MiB && (size_t)NBATCH * NH * 128 * RPB == 34 * MiB, "K8 | VT8 | XB fill the K/V region");
static_assert(WS_P + (size_t)T * NP * 2 <= WS_Z && WS_KV + (size_t)T * NKV * 2 <= WS_Q && WS_Q + (size_t)T * NQ * 2 <= WS_HM && WS_HM + (size_t)T * DM * 2 <= WS_END, "ws map");
constexpr int CW_BAR = 4096;
constexpr int CW_Q1 = 12288, CW_Q2 = 12352;
constexpr int CW_CNT = 16384;

constexpr int RING_BYTES = 131072;
constexpr int L_CIDX = RING_BYTES, L_CWA = L_CIDX + 8192, L_CWB = L_CWA + 8192, L_TAB = L_CWB + 8192, L_MISC = L_TAB + 512;
constexpr int LDS_BYTES = L_MISC + 512;
constexpr int MAXU = 8;
static_assert(MAXU * 256 == 4 * 512, "moe_setup: four cache entries per thread");

__device__ __forceinline__ unsigned cvt_pk(float lo, float hi) { unsigned r; asm("v_cvt_pk_bf16_f32 %0, %1, %2" : "=v"(r) : "v"(lo), "v"(hi)); return r; }
__device__ __forceinline__ float bf2f(unsigned h) { return __builtin_bit_cast(float, h << 16); }
__device__ __forceinline__ float bflo(unsigned w) { return __builtin_bit_cast(float, w << 16); }
__device__ __forceinline__ float bfhi(unsigned w) { return __builtin_bit_cast(float, w & 0xffff0000u); }
template <int CTRL> __device__ __forceinline__ float dppf(float v) { return __builtin_bit_cast(float, __builtin_amdgcn_update_dpp(0, __builtin_bit_cast(int, v), CTRL, 0xf, 0xf, true)); }
__device__ __forceinline__ float wave_sum(float v) {
    v += dppf<0xB1>(v);
    v += dppf<0x4E>(v);
    v += dppf<0x141>(v);
    v += dppf<0x140>(v);
    { auto rr = __builtin_amdgcn_permlane16_swap(__float_as_uint(v), __float_as_uint(v), false, false); v = __uint_as_float(rr[0]) + __uint_as_float(rr[1]); }
    { auto rr = __builtin_amdgcn_permlane32_swap(__float_as_uint(v), __float_as_uint(v), false, false); v = __uint_as_float(rr[0]) + __uint_as_float(rr[1]); }
    return v;
}
__device__ __forceinline__ float sigmoidf_(float x) { return __builtin_amdgcn_rcpf(1.f + __builtin_amdgcn_exp2f(-1.4426950408889634f * x)); }
__device__ __forceinline__ unsigned pk_fp8x4(float a, float b, float c, float d) {
    a = __builtin_amdgcn_fmed3f(a, -448.f, 448.f); b = __builtin_amdgcn_fmed3f(b, -448.f, 448.f); c = __builtin_amdgcn_fmed3f(c, -448.f, 448.f); d = __builtin_amdgcn_fmed3f(d, -448.f, 448.f);
    int w = 0; w = __builtin_amdgcn_cvt_pk_fp8_f32(a, b, w, false); w = __builtin_amdgcn_cvt_pk_fp8_f32(c, d, w, true); return (unsigned)w;
}
constexpr int SH_H2 = 2, SH_WGU = 6, SH_ACT = 3, SH_WD = 5, SH_H = 2, SH_WIN = 6, SH_Q = 3, SH_K = 3, SH_V = 3, SH_P = 4, SH_MIX = 3, SH_WOUT = 6, SH_LAT = 2, SH_WKQ = 5, SH_QC = 6, SH_Z = 3, SH_WPOOL = 6;
constexpr float QK_C = 0.07216878364870322f * 1.4426950408889634f;
__device__ __forceinline__ int lane_now() { int l; asm volatile("v_mbcnt_lo_u32_b32 %0, -1, 0\n\tv_mbcnt_hi_u32_b32 %0, -1, %0" : "=v"(l)); return l; }
__device__ __forceinline__ int tid_from(int wave_s) { return wave_s * 64 + lane_now(); }
#define LDS_WAIT() asm volatile("s_waitcnt lgkmcnt(0)" ::: "memory")
#define VM_WAIT() asm volatile("s_waitcnt vmcnt(0)" ::: "memory")

#define XB_TMO      128
#define XB_XCNT(j)  (256  + 64 * (j))
#define XB_XSUB(j)  (1280 + 64 * (j))
#define XB_XGEN(j)  (2304 + 64 * (j))
#define XB_TOP      3328
#define XB_TOPGEN   3392
#define XCD_BAR_WORDS 3456
#define XB_SPIN_CAP (1u << 18)
__device__ __forceinline__ unsigned xb_ld(unsigned* p)              { return __hip_atomic_load(p, __ATOMIC_RELAXED, __HIP_MEMORY_SCOPE_AGENT); }
__device__ __forceinline__ unsigned xb_add(unsigned* p, unsigned v) { return __hip_atomic_fetch_add(p, v, __ATOMIC_RELAXED, __HIP_MEMORY_SCOPE_AGENT); }
__device__ __forceinline__ unsigned xb_xcc_id() { return (unsigned)__builtin_amdgcn_s_getreg((3 << 11) | 20) & 0xFu; }
#define XB_SPIN(cond, bar) do { unsigned _sp = 0; while (cond) { __builtin_amdgcn_s_sleep(1); \
    if ((++_sp & 255u) == 0u) { if (xb_ld(&(bar)[XB_TMO])) break; if (_sp > XB_SPIN_CAP) { atomicAdd(&(bar)[XB_TMO], 1u); break; } } } } while (0)
struct XcdBarrier { unsigned* bar; unsigned x; volatile LAS unsigned* st; };
__device__ __forceinline__ XcdBarrier xcd_barrier_post(unsigned* bar, volatile LAS unsigned* st, const bool leader) {
    XcdBarrier b; b.bar = bar; b.x = xb_xcc_id(); b.st = st;
    if (leader) (void)xb_add(&bar[XB_XCNT(b.x)], 1u);
    return b;
}
__device__ __forceinline__ void xcd_barrier_complete(unsigned* bar, unsigned x, unsigned& nloc, unsigned& nx) {
    const unsigned G = gridDim.x * gridDim.y * gridDim.z;
    unsigned sum, cnt, mine, sp = 0u;
    for (;;) {
        sum = 0u; cnt = 0u; mine = 0u;
#pragma unroll
        for (unsigned j = 0; j < 16; ++j) { const unsigned c = xb_ld(&bar[XB_XCNT(j)]); sum += c; cnt += (c > 0u) ? 1u : 0u; mine = (j == x) ? c : mine; }
        if (sum == G) break;
        __builtin_amdgcn_s_sleep(1);
        if ((++sp & 255u) == 0u) { if (xb_ld(&bar[XB_TMO])) break; if (sp > XB_SPIN_CAP) { atomicAdd(&bar[XB_TMO], 1u); break; } }
    }
    nloc = mine > 0u ? mine : 1u; nx = cnt > 0u ? cnt : 1u;
}
__device__ __forceinline__ void xcd_barrier(const XcdBarrier& b, const bool leader) {
    asm volatile("s_waitcnt vmcnt(0)" ::: "memory");
    __syncthreads();
    if (leader) {
        unsigned* bar = b.bar; const unsigned bx = b.x;
        __builtin_amdgcn_s_waitcnt(0);
        unsigned nloc = b.st[0], nx = b.st[1];
        if (nloc == 0u) { xcd_barrier_complete(bar, bx, nloc, nx); b.st[0] = nloc; b.st[1] = nx; }
        const unsigned old = xb_add(&bar[XB_XSUB(bx)], 1u);
        const unsigned gen = old / nloc;
        if (old + 1u == (gen + 1u) * nloc) {
            __builtin_amdgcn_fence(__ATOMIC_RELEASE, "agent");
            asm volatile("s_waitcnt vmcnt(0)" ::: "memory");
            const unsigned og = xb_add(&bar[XB_TOP], 1u);
            const unsigned tgt = (og / nx + 1u) * nx;
            if (og + 1u != tgt) XB_SPIN(xb_ld(&bar[XB_TOP]) < tgt, bar);
            __builtin_amdgcn_fence(__ATOMIC_ACQUIRE, "agent");
            xb_add(&bar[XB_XGEN(bx)], 1u);
            asm volatile("s_waitcnt vmcnt(0)" ::: "memory");
        } else {
            XB_SPIN(xb_ld(&bar[XB_XGEN(bx)]) == gen, bar);
            __builtin_amdgcn_fence(__ATOMIC_ACQUIRE, "agent");
            asm volatile("s_waitcnt vmcnt(0)" ::: "memory");
        }
    }
    __syncthreads();
}

struct Args { const float* in[25]; float* out; unsigned char* ws; int ph_lo, ph_hi; };
struct Frame {
    LAS unsigned char* lds;
    LAS unsigned char* ldsx;
    int tid, lane, wave, vcu, G, bx;
    const __attribute__((address_space(4))) Args* ap;
    __device__ __forceinline__ void fresh() { ap = (const __attribute__((address_space(4))) Args*)__builtin_amdgcn_kernarg_segment_ptr(); asm volatile("" : "+s"(ap));
        int t = tid_from(wave); asm volatile("" : "+v"(t)); tid = t; lane = t & 63;
        unsigned z = 0; asm volatile("" : "+s"(z)); ldsx = lds + z;
        int g = gridDim.x, b = blockIdx.x; asm volatile("" : "+s"(g), "+s"(b)); G = g; bx = b; vcu = (g % 8 == 0) ? (b % 8) * (g / 8) + b / 8 : b; }
    __device__ __forceinline__ const float* in(int i) const { return ap->in[i]; }
    __device__ __forceinline__ float* out() const { return ap->out; }
    __device__ __forceinline__ unsigned char* ws() const { return ap->ws; }
    __device__ __forceinline__ unsigned* ctl() const { return (unsigned*)(ap->ws + WS_CTL); }
    __device__ __forceinline__ float* xctx() const { return (float*)(ap->ws + WS_XCTX); }
    __device__ __forceinline__ bf16* P() const { return (bf16*)(ap->ws + WS_P); }
    __device__ __forceinline__ bf16* ACT() const { return (bf16*)(ap->ws + WS_P); }
    __device__ __forceinline__ bf16* Z() const { return (bf16*)(ap->ws + WS_Z); }
    __device__ __forceinline__ bf16* KPE() const { return (bf16*)(ap->ws + WS_KPE); }
    __device__ __forceinline__ bf16* KV() const { return (bf16*)(ap->ws + WS_KV); }
    __device__ __forceinline__ bf16* Q() const { return (bf16*)(ap->ws + WS_Q); }
    __device__ __forceinline__ bf16* HM() const { return (bf16*)(ap->ws + WS_HM); }
    __device__ __forceinline__ unsigned char* K8() const { return ap->ws + WS_KV; }
    __device__ __forceinline__ unsigned char* VT8() const { return ap->ws + WS_KV + 34 * MiB; }
    __device__ __forceinline__ unsigned char* Q8() const { return ap->ws + WS_Q; }
    __device__ __forceinline__ unsigned char* KPE8() const { return ap->ws + WS_KPE; }
    __device__ __forceinline__ unsigned char* M8() const { return ap->ws + WS_Z; }
    __device__ __forceinline__ bf16* XB() const { return (bf16*)(ap->ws + WS_XB); }
    __device__ __forceinline__ float* mod() const { return (float*)(ap->ws + WS_MOD); }
    __device__ __forceinline__ float* cosT() const { return (float*)(ap->ws + WS_COS); }
    __device__ __forceinline__ float* sinT() const { return (float*)(ap->ws + WS_SIN); }
    __device__ __forceinline__ int* ltok() const { return (int*)(ap->ws + WS_LTOK); }
    __device__ __forceinline__ float* lwa() const { return (float*)(ap->ws + WS_LWA); }
    __device__ __forceinline__ float* lwb() const { return (float*)(ap->ws + WS_LWB); }
};
__device__ __forceinline__ const float* xin_row(const Frame& F, int r) { const int b = r / RPB, j = r - b * RPB; return j < CTX ? F.in(2) + (size_t)(b * CTX + j) * DM : F.in(0) + (size_t)(b * SEQ + j - CTX) * DM; }
__device__ __forceinline__ bf16* xres_row(const Frame& F, int r) { return F.XB() + (size_t)r * DM; }
__device__ __forceinline__ f32x4 ld4bf(const bf16* p) { const u32x2 w = *(const u32x2*)p; return (f32x4){bflo(w.x), bfhi(w.x), bflo(w.y), bfhi(w.y)}; }
__device__ __forceinline__ int mod_row(int r) { const int b = r / RPB, j = r - b * RPB; return j < CTX ? 4 : b; }

namespace pg8 {
constexpr int BM = 256, BK = 64, HALF = 128, HTB = HALF * BK * 2, NXCD = 8, WGM = 8;
__device__ __forceinline__ int lds_byte(int r, int c) { const int st = (r >> 4) * 2 + (c >> 5), rr = r & 15, cc = c & 31, ob = rr * 64 + cc * 2; return st * 1024 + (ob ^ (((ob >> 9) & 1) << 5)); }
__device__ __forceinline__ void stage_rc(int b, int& R, int& C) { const int st = b / 1024, sb = b % 1024, swz = sb ^ (((sb >> 9) & 1) << 5); R = (st >> 1) * 16 + swz / 64; C = (st & 1) * 32 + (swz % 64) / 2; }
__device__ __forceinline__ int perm32(int rho) { const int n = rho >> 4, i = rho & 15; return 8 * (i >> 2) + 4 * n + (i & 3); }

struct Unit { int pm, pn, p, nrows, slot, arow0, ea, eb, kind; };

__device__ __forceinline__ void static_map(int L, int nM, int nN, int& pm, int& pn) {
    const int nwg = nM * nN; int wgid = L; { const int q = nwg / NXCD, r = nwg % NXCD, xcd = wgid % NXCD, off = wgid / NXCD; wgid = (xcd < r ? xcd * (q + 1) : r * (q + 1) + (xcd - r) * q) + off; }
    const int nig = WGM * nN, gid = wgid / nig, fm = gid * WGM, gsz = (nM - fm) < WGM ? (nM - fm) : WGM;
    pm = fm + ((wgid % nig) % gsz); pn = (wgid % nig) / gsz;
}
__device__ __forceinline__ bool static_next(int i, int G, int c, int nM, int nN, int& pm, int& pn) {
    const int nwg = nM * nN; const long L = (long)i * G + c; if (L >= nwg) return false;
    int wgid = (int)L; { const int q = nwg / NXCD, r = nwg % NXCD, xcd = wgid % NXCD, off = wgid / NXCD; wgid = (xcd < r ? xcd * (q + 1) : r * (q + 1) + (xcd - r) * q) + off; }
    const int nig = WGM * nN, gid = wgid / nig, fm = gid * WGM, gsz = (nM - fm) < WGM ? (nM - fm) : WGM;
    pm = fm + ((wgid % nig) % gsz); pn = (wgid % nig) / gsz; return true;
}
struct DenseSched {
    const bf16* A; const bf16* Bt; int lda, ldb, nM, nN, G, c, a_shift, a_stride; bool lat_only;
    int K; int pn_off;
    __device__ __forceinline__ bool next(int i, Unit& u) const { u.p = 0; u.nrows = 256; u.slot = 0; u.arow0 = 0; u.ea = 0; u.eb = 0; u.kind = 0; const bool ok = static_next(i, G, c, nM, nN, u.pm, u.pn);
        if (lat_only) u.pm += (u.pm >> 4) + 1; u.pn += pn_off; return ok; }
    static constexpr bool FP8 = false, MIXED = false;
    __device__ __forceinline__ int scale_a() const { return 127; }
    __device__ __forceinline__ int scale_b() const { return 127; }
    __device__ __forceinline__ int nt(const Unit&) const { return K / BK; }
    __device__ __forceinline__ int ldbv(const Unit&) const { return ldb; }
    __device__ __forceinline__ const char* a_base(const Unit& u) const { return (const char*)(A + (size_t)((u.pn >> a_shift) * a_stride)); }
    __device__ __forceinline__ unsigned a_off(const Unit& u, int row, int col) const { return (unsigned)(((u.pm * 256 + row) * lda + col) * 2); }
    __device__ __forceinline__ const char* b_tile(const Unit& u, int t) const { return (const char*)(Bt + (size_t)u.pn * 256 * ldb + (size_t)t * BK); }
};
struct TriSched {
    const unsigned char* ws; size_t wl; int G, c, nMq; bool lat_only;
    __device__ __forceinline__ bool next(int i, Unit& u) const { u.p = 0; u.nrows = 256; u.slot = 0; u.arow0 = 0; u.ea = 0; u.eb = 0;
        int L = i * G + c; const int n0 = (T / 256) * 16, n1 = nMq * 12, n2 = nMq * 8;
        if (L < n0) { u.kind = 0; static_map(L, T / 256, 16, u.pm, u.pn); return true; } L -= n0;
        if (L < n1) { u.kind = 1; static_map(L, nMq, 12, u.pm, u.pn); if (lat_only) u.pm += (u.pm >> 4) + 1; return true; } L -= n1;
        if (L < n2) { u.kind = 2; static_map(L, nMq, 8, u.pm, u.pn); if (lat_only) u.pm += (u.pm >> 4) + 1; return true; }
        return false; }
    static constexpr bool FP8 = false, MIXED = false;
    __device__ __forceinline__ int scale_a() const { return 127; }
    __device__ __forceinline__ int scale_b() const { return 127; }
    __device__ __forceinline__ int nt(const Unit& u) const { return u.kind == 0 ? 8 : (u.kind == 1 ? 6 : 4); }
    __device__ __forceinline__ int ldbv(const Unit& u) const { return u.kind == 0 ? 512 : (u.kind == 1 ? 384 : 256); }
    __device__ __forceinline__ const char* a_base(const Unit& u) const { const size_t off = u.kind == 0 ? WS_P : (u.kind == 1 ? WS_P + (size_t)P_Q * 2 : WS_Z + (size_t)(u.pn >> 1) * 512); return (const char*)(ws + off); }
    __device__ __forceinline__ unsigned a_off(const Unit& u, int row, int col) const { return (unsigned)(((u.pm * 256 + row) * (u.kind == 2 ? NZ : NP) + col) * 2); }
    __device__ __forceinline__ const char* b_tile(const Unit& u, int t) const { const size_t off = u.kind == 0 ? LW_KVB : (u.kind == 1 ? LW_QB : LW_POOL);
        return (const char*)(ws + wl + off + ((size_t)u.pn * 256 * ldbv(u) + (size_t)t * BK) * 2); }
};
struct A8Sched {
    const unsigned char* A; const unsigned char* W8; int G, c;
    static constexpr bool FP8 = true, MIXED = false;
    __device__ __forceinline__ int scale_a() const { return 127 - SH_H; }
    __device__ __forceinline__ int scale_b() const { return 127 - SH_WIN; }
    __device__ __forceinline__ bool next(int i, Unit& u) const { u.p = 0; u.nrows = 256; u.slot = 0; u.arow0 = 0; u.ea = 0; u.eb = 0; u.kind = 0;
        return static_next(i, G, c, T / 256, 24, u.pm, u.pn); }
    __device__ __forceinline__ int nt(const Unit&) const { return DM / 128; }
    __device__ __forceinline__ int ldbv(const Unit&) const { return DM / 2; }
    __device__ __forceinline__ const char* a_base(const Unit&) const { return (const char*)A; }
    __device__ __forceinline__ unsigned a_off(const Unit& u, int row, int col) const { return (unsigned)((u.pm * 256 + row) * DM + col * 2); }
    __device__ __forceinline__ const char* b_tile(const Unit& u, int t) const { return (const char*)(W8 + (size_t)u.pn * 256 * DM + (size_t)t * 128); }
};
struct D8Sched {
    const unsigned char* A; const unsigned char* W8; int G, c, nM; bool lat_only;
    static constexpr bool FP8 = true, MIXED = false;
    __device__ __forceinline__ int scale_a() const { return 127 - SH_MIX; }
    __device__ __forceinline__ int scale_b() const { return 127 - SH_WOUT; }
    __device__ __forceinline__ bool next(int i, Unit& u) const { u.p = 0; u.nrows = 256; u.slot = 0; u.arow0 = 0; u.ea = 0; u.eb = 0; u.kind = 0;
        const bool ok = static_next(i, G, c, nM, 8, u.pm, u.pn); if (lat_only) u.pm += (u.pm >> 4) + 1; return ok; }
    __device__ __forceinline__ int nt(const Unit&) const { return DM / 128; }
    __device__ __forceinline__ int ldbv(const Unit&) const { return DM / 2; }
    __device__ __forceinline__ const char* a_base(const Unit&) const { return (const char*)A; }
    __device__ __forceinline__ unsigned a_off(const Unit& u, int row, int col) const { return (unsigned)((u.pm * 256 + row) * DM + col * 2); }
    __device__ __forceinline__ const char* b_tile(const Unit& u, int t) const { return (const char*)(W8 + (size_t)u.pn * 256 * DM + (size_t)t * 128); }
};
struct Pool8Sched {
    const unsigned char* A; const unsigned char* W8; int G, c, nM; bool lat_only;
    static constexpr bool FP8 = true, MIXED = false;
    __device__ __forceinline__ int scale_a() const { return 127 - SH_Z; }
    __device__ __forceinline__ int scale_b() const { return 127 - SH_WPOOL; }
    __device__ __forceinline__ bool next(int i, Unit& u) const { u.p = 0; u.nrows = 256; u.slot = 0; u.arow0 = 0; u.ea = 0; u.eb = 0; u.kind = 0;
        const bool ok = static_next(i, G, c, nM, 8, u.pm, u.pn); if (lat_only) u.pm += (u.pm >> 4) + 1; return ok; }
    __device__ __forceinline__ int nt(const Unit&) const { return 256 / 128; }
    __device__ __forceinline__ int ldbv(const Unit&) const { return 256 / 2; }
    __device__ __forceinline__ const char* a_base(const Unit& u) const { return (const char*)A + (u.pn >> 1) * 256; }
    __device__ __forceinline__ unsigned a_off(const Unit& u, int row, int col) const { return (unsigned)((u.pm * 256 + row) * NZ + col * 2); }
    __device__ __forceinline__ const char* b_tile(const Unit& u, int t) const { return (const char*)(W8 + (size_t)u.pn * 256 * 256 + (size_t)t * 128); }
};
struct KQ8Sched {
    const unsigned char* ws; size_t wl; int G, c, nMq; bool lat_only;
    static constexpr bool FP8 = true, MIXED = false;
    __device__ __forceinline__ int scale_a() const { return 127 - SH_LAT; }
    __device__ __forceinline__ int scale_b() const { return 127 - SH_WKQ; }
    __device__ __forceinline__ bool next(int i, Unit& u) const { u.p = 0; u.nrows = 256; u.slot = 0; u.arow0 = 0; u.ea = 0; u.eb = 0;
        int L = i * G + c; const int n0 = (T / 256) * 16, n1 = nMq * 12;
        if (L < n0) { u.kind = 0; static_map(L, T / 256, 16, u.pm, u.pn); return true; } L -= n0;
        if (L < n1) { u.kind = 1; static_map(L, nMq, 12, u.pm, u.pn); if (lat_only) u.pm += (u.pm >> 4) + 1; return true; }
        return false; }
    __device__ __forceinline__ int nt(const Unit&) const { return 4; }
    __device__ __forceinline__ int ldbv(const Unit&) const { return 256; }
    __device__ __forceinline__ const char* a_base(const Unit& u) const { return (const char*)(ws + WS_P + (u.kind == 0 ? 0 : (size_t)P_Q * 2)); }
    __device__ __forceinline__ unsigned a_off(const Unit& u, int row, int col) const { return (unsigned)((u.pm * 256 + row) * (NP * 2) + col * 2); }
    __device__ __forceinline__ const char* b_tile(const Unit& u, int t) const { return (const char*)(ws + wl + (u.kind == 0 ? LW_KVB : LW_QB) + (size_t)u.pn * 256 * 512 + (size_t)t * 128); }
};
__device__ __forceinline__ bool moe_next(int i, int G, int c, int nN, const volatile LAS int* tab, Unit& u) {
    if (i >= MAXU) return false;
    const LAS int* d = (const LAS int*)tab + 64 + 8 * i; const i32x4 a = *(const LAS i32x4*)d, b = *(const LAS i32x4*)(d + 4);
    if (!a[0]) return false;
    u.pn = a[1]; u.p = a[2]; u.pm = a[3]; u.nrows = b[0]; u.arow0 = b[1]; u.ea = b[2]; u.eb = b[3]; u.slot = i; u.kind = 0; return true;
}
struct MoeUpSched {
    const unsigned char* A; const unsigned char* Wgu; int G, c; const volatile LAS int* tab; const volatile LAS int* cidx;
    static constexpr bool FP8 = true, MIXED = false;
    __device__ __forceinline__ int scale_a() const { return 127 - SH_H2; }
    __device__ __forceinline__ int scale_b() const { return 127 - SH_WGU; }
    __device__ __forceinline__ bool next(int i, Unit& u) const { return moe_next(i, G, c, 12, tab, u); }
    __device__ __forceinline__ int nt(const Unit&) const { return DM / 128; }
    __device__ __forceinline__ int ldbv(const Unit&) const { return DM / 2; }
    __device__ __forceinline__ const char* a_base(const Unit&) const { return (const char*)A; }
    __device__ __forceinline__ unsigned a_off(const Unit& u, int row, int col) const { return (unsigned)(cidx[u.slot * 256 + row] * DM + col * 2); }
    __device__ __forceinline__ const char* b_tile(const Unit& u, int t) const { const int seg = u.pn >> 2, e = seg == 0 ? 16 : (seg == 1 ? u.ea : u.eb);
        return (const char*)(Wgu + ((size_t)e * 1024 + (size_t)(u.pn & 3) * 256) * DM + (size_t)t * 128); }
};
struct MoeDownSched {
    const unsigned char* A; const unsigned char* Wd; int G, c; const volatile LAS int* tab;
    static constexpr bool FP8 = true, MIXED = false;
    __device__ __forceinline__ int scale_a() const { return 127 - SH_ACT; }
    __device__ __forceinline__ int scale_b() const { return 127 - SH_WD; }
    __device__ __forceinline__ bool next(int i, Unit& u) const { return moe_next(i, G, c, 8, tab, u); }
    __device__ __forceinline__ int nt(const Unit&) const { return NACT / 128; }
    __device__ __forceinline__ int ldbv(const Unit&) const { return 512 / 2; }
    __device__ __forceinline__ const char* a_base(const Unit&) const { return (const char*)A; }
    __device__ __forceinline__ unsigned a_off(const Unit& u, int row, int col) const { return (unsigned)((u.arow0 + row) * NACT + col * 2); }
    __device__ __forceinline__ const char* b_tile(const Unit& u, int t) const { const int seg = t >> 2, e = ((16 | (u.ea << 8) | (u.eb << 16)) >> (8 * seg)) & 0xff;
        return (const char*)(Wd + ((size_t)e * DM + (size_t)u.pn * 256) * 512 + (size_t)(t & 3) * 128); }
};

template <class Epi, class Sched, bool ALIGN_EPI>
__device__ __forceinline__ void gemm_phase(LAS unsigned char* lds, const int wave, const Sched& S, const Epi& E) {
    int tid = tid_from(wave); asm volatile("" : "+v"(tid));
    const int wid = wave, lane = tid & 63, wr = wid >> 2, wc = wid & 3, fr = lane & 15, fq = lane >> 4;
    unsigned voffB[2];
    const size_t kstep = (size_t)(BK * 2);
    size_t hstepB;
#define PG8_BOFF(u) do { int _t = tid; asm volatile("" : "+v"(_t)); const int _ldb = S.ldbv(u); hstepB = (size_t)HALF * _ldb * 2; _Pragma("unroll") for (int _i = 0; _i < 2; ++_i) { int R, C; stage_rc(_t * 16 + _i * 8192, R, C); \
        const int Rb = (R & ~31) + perm32(R & 31); voffB[_i] = (unsigned)(Rb * _ldb + C) * 2u; } } while (0)
    const unsigned ldsw = (unsigned)wid * 1024u;
    constexpr bool FP8 = Sched::FP8;
    constexpr bool MIXED = Sched::MIXED;
    bool f8 = FP8;
    int aoff = FP8 ? lds_byte(wr * 64 + fr, (fq >> 1) * 32 + (fq & 1) * 8) : lds_byte(wr * 64 + fr, fq * 8), boff = FP8 ? lds_byte(wc * 32 + fr, (fq >> 1) * 32 + (fq & 1) * 8) : lds_byte(wc * 32 + fr, fq * 8);
    int aoffH = FP8 ? (aoff ^ 32) : aoff + 1024, boffH = FP8 ? (boff ^ 32) : boff + 1024;
#define PG8_FRAG(u) do { if constexpr (MIXED) { f8 = S.unit_f8(u); int _l = tid; asm volatile("" : "+v"(_l)); const int _fr = _l & 15, _fq = (_l & 63) >> 4; \
        aoff = lds_byte(wr * 64 + _fr, _fq * (f8 ? 16 : 8)); boff = lds_byte(wc * 32 + _fr, _fq * (f8 ? 16 : 8)); aoffH = aoff + (f8 ? 16 : 1024); boffH = boff + (f8 ? 16 : 1024); } } while (0)
    const int scA = S.scale_a() * 0x01010101, scB = S.scale_b() * 0x01010101;
#define PG8_SA(b, h) (((b) * 2 + (h)) * HTB)
#define PG8_SB(b, h) ((4 + (b) * 2 + (h)) * HTB)
#define PG8_STAGE(bufoff, gbase, voff) do { _Pragma("unroll") for (int _i = 0; _i < 2; ++_i) \
        __builtin_amdgcn_global_load_lds((const unsigned*)((const char*)(gbase) + (voff)[_i]), (LAS unsigned*)(lds + (bufoff) + ldsw + _i * 8192), 16, 0, 0); } while (0)
#define PG8_CAT(lo, hi) __builtin_shufflevector(lo, hi, 0, 1, 2, 3, 4, 5, 6, 7)
#define PG8_LO(x) __builtin_bit_cast(bf16x8, __builtin_shufflevector(x, x, 0, 1, 2, 3))
#define PG8_HI(x) __builtin_bit_cast(bf16x8, __builtin_shufflevector(x, x, 4, 5, 6, 7))
#define PG8_LDA(dst, b, h) do { _Pragma("unroll") for (int m = 0; m < 4; ++m) { \
        if constexpr (MIXED) { const i32x4 _lo = *(const LAS i32x4*)(lds + PG8_SA(b, h) + aoff + m * 2048), _hi = *(const LAS i32x4*)(lds + PG8_SA(b, h) + aoffH + m * 2048); dst##8[m] = PG8_CAT(_lo, _hi); } \
        else if constexpr (FP8) { const i32x4 _lo = *(const LAS i32x4*)(lds + PG8_SA(b, h) + aoff + m * 2048), _hi = *(const LAS i32x4*)(lds + PG8_SA(b, h) + aoffH + m * 2048); dst##8[m] = PG8_CAT(_lo, _hi); } \
        else { _Pragma("unroll") for (int k = 0; k < 2; ++k) dst[m][k] = *(const LAS bf16x8*)(lds + PG8_SA(b, h) + aoff + m * 2048 + k * 1024); } } } while (0)
#define PG8_LDB(dst, b, h) do { _Pragma("unroll") for (int n = 0; n < 2; ++n) { \
        if constexpr (MIXED) { const i32x4 _lo = *(const LAS i32x4*)(lds + PG8_SB(b, h) + boff + n * 2048), _hi = *(const LAS i32x4*)(lds + PG8_SB(b, h) + boffH + n * 2048); dst##8[n] = PG8_CAT(_lo, _hi); } \
        else if constexpr (FP8) { const i32x4 _lo = *(const LAS i32x4*)(lds + PG8_SB(b, h) + boff + n * 2048), _hi = *(const LAS i32x4*)(lds + PG8_SB(b, h) + boffH + n * 2048); dst##8[n] = PG8_CAT(_lo, _hi); } \
        else { _Pragma("unroll") for (int k = 0; k < 2; ++k) dst[n][k] = *(const LAS bf16x8*)(lds + PG8_SB(b, h) + boff + n * 2048 + k * 1024); } } } while (0)
#define PG8_MMA(ai, bj, At, Bt) do { __builtin_amdgcn_s_setprio(1); \
        if constexpr (MIXED) { if (f8) { _Pragma("unroll") for (int m = 0; m < 4; ++m) _Pragma("unroll") for (int n = 0; n < 2; ++n) \
                acc[ai][bj][m][n] = __builtin_amdgcn_mfma_scale_f32_16x16x128_f8f6f4(Bt##8[n], At##8[m], acc[ai][bj][m][n], 0, 0, 0, scB, 0, scA); } \
            else { _Pragma("unroll") for (int m = 0; m < 4; ++m) _Pragma("unroll") for (int n = 0; n < 2; ++n) { \
                acc[ai][bj][m][n] = __builtin_amdgcn_mfma_f32_16x16x32_bf16(PG8_LO(Bt##8[n]), PG8_LO(At##8[m]), acc[ai][bj][m][n], 0, 0, 0); \
                acc[ai][bj][m][n] = __builtin_amdgcn_mfma_f32_16x16x32_bf16(PG8_HI(Bt##8[n]), PG8_HI(At##8[m]), acc[ai][bj][m][n], 0, 0, 0); } } } \
        else { _Pragma("unroll") for (int m = 0; m < 4; ++m) _Pragma("unroll") for (int n = 0; n < 2; ++n) { \
        if constexpr (FP8) acc[ai][bj][m][n] = __builtin_amdgcn_mfma_scale_f32_16x16x128_f8f6f4(Bt##8[n], At##8[m], acc[ai][bj][m][n], 0, 0, 0, scB, 0, scA); \
        else { _Pragma("unroll") for (int k = 0; k < 2; ++k) acc[ai][bj][m][n] = __builtin_amdgcn_mfma_f32_16x16x32_bf16(Bt[n][k], At[m][k], acc[ai][bj][m][n], 0, 0, 0); } } } \
        __builtin_amdgcn_s_setprio(0); } while (0)
#define PG8_WAIT_V(n) asm volatile("s_waitcnt vmcnt(" #n ")" ::: "memory")
#define PG8_WAIT_L(n) asm volatile("s_waitcnt lgkmcnt(" #n ")" ::: "memory")
#define PG8_BAR __builtin_amdgcn_s_barrier()
#define PG8_SCHED __builtin_amdgcn_sched_barrier(0)
#define PG8_AOFF(u) do { int _t = tid; asm volatile("" : "+v"(_t)); _Pragma("unroll") for (int _i = 0; _i < 2; ++_i) { int R, C; stage_rc(_t * 16 + _i * 8192, R, C); \
        oA0[_i] = S.a_off(u, R, C); oA1[_i] = S.a_off(u, HALF + R, C); } } while (0)
    Unit cur, nxt; int ui = 0;
    if (!S.next(0, cur)) return;
    f32x4 acc[2][2][4][2];
    float zf = 0.f; asm volatile("" : "+v"(zf));
#pragma unroll
    for (int a = 0; a < 2; ++a)
#pragma unroll
        for (int b = 0; b < 2; ++b)
#pragma unroll
            for (int m = 0; m < 4; ++m)
#pragma unroll
                for (int n = 0; n < 2; ++n) acc[a][b][m][n] = (f32x4){zf, zf, zf, zf};
    bf16x8 At[4][2], B0[2][2], B1[2][2]; i32x8 At8[4], B08[2], B18[2];
    unsigned oA0[2], oA1[2];
    PG8_AOFF(cur); PG8_BOFF(cur); PG8_FRAG(cur);
    int nt = S.nt(cur); asm volatile("" : "+s"(nt));
    const char* cA = S.a_base(cur);
    {
        const char* b0 = S.b_tile(cur, 0); const char* b1 = S.b_tile(cur, 1);
        PG8_STAGE(PG8_SB(0, 0), b0, voffB); PG8_STAGE(PG8_SB(0, 1), b0 + hstepB, voffB); PG8_STAGE(PG8_SA(0, 0), cA, oA0); PG8_STAGE(PG8_SA(0, 1), cA, oA1);
        if (wr == 1) PG8_BAR;
        PG8_WAIT_V(2); PG8_BAR;
        PG8_STAGE(PG8_SB(1, 0), b1, voffB); PG8_STAGE(PG8_SA(1, 0), cA + kstep, oA0); PG8_STAGE(PG8_SB(1, 1), b1 + hstepB, voffB);
        PG8_WAIT_V(6); PG8_BAR;
    }
    for (;;) {
        const bool has_next = S.next(ui + 1, nxt);
        for (int t = 0; t < nt; t += 2) {
            const bool last = (t == nt - 2);
            const bool sw = last && has_next;
            PG8_LDB(B0, 0, 0); PG8_LDB(B1, 0, 1); PG8_SCHED; PG8_LDA(At, 0, 0); PG8_STAGE(PG8_SA(1, 1), cA + (size_t)(t + 1) * kstep, oA1);
            if (sw) { PG8_AOFF(nxt); PG8_BOFF(nxt); cA = S.a_base(nxt); }
            const char* a2 = last ? cA : cA + (size_t)(t + 2) * kstep;
            const char* b2 = last ? (has_next ? S.b_tile(nxt, 0) : S.b_tile(cur, 0)) : S.b_tile(cur, t + 2);
            const char* b3 = last ? (has_next ? S.b_tile(nxt, 1) : S.b_tile(cur, 1)) : S.b_tile(cur, t + 3);
            PG8_WAIT_V(8); PG8_WAIT_L(0); PG8_BAR; PG8_MMA(0, 0, At, B0); PG8_MMA(0, 1, At, B1); PG8_BAR; PG8_SCHED;
            PG8_LDA(At, 0, 1); PG8_STAGE(PG8_SB(0, 0), b2, voffB); PG8_STAGE(PG8_SB(0, 1), b2 + hstepB, voffB); PG8_STAGE(PG8_SA(0, 0), a2, oA0);
            PG8_WAIT_V(8); PG8_WAIT_L(0); PG8_BAR; PG8_MMA(1, 0, At, B0); PG8_MMA(1, 1, At, B1); PG8_BAR; PG8_SCHED;
            PG8_LDB(B0, 1, 0); PG8_LDB(B1, 1, 1); PG8_SCHED; PG8_LDA(At, 1, 0); PG8_STAGE(PG8_SA(0, 1), a2, oA1);
            PG8_WAIT_V(8); PG8_WAIT_L(0); PG8_BAR; PG8_MMA(0, 0, At, B0); PG8_MMA(0, 1, At, B1); PG8_BAR; PG8_SCHED;
            PG8_LDA(At, 1, 1); PG8_STAGE(PG8_SB(1, 0), b3, voffB); PG8_STAGE(PG8_SB(1, 1), b3 + hstepB, voffB); PG8_STAGE(PG8_SA(1, 0), a2 + kstep, oA0);
            PG8_WAIT_V(8); PG8_WAIT_L(0); PG8_BAR; PG8_MMA(1, 0, At, B0); PG8_MMA(1, 1, At, B1); PG8_BAR; PG8_SCHED;
        }
        if constexpr (ALIGN_EPI) { if (wr == 0) PG8_BAR; }
        E(acc, cur, wr, wc, fr, fq);
        if (!has_next) break;
        asm volatile("" : "+v"(zf));
#pragma unroll
        for (int a = 0; a < 2; ++a)
#pragma unroll
            for (int b = 0; b < 2; ++b)
#pragma unroll
                for (int m = 0; m < 4; ++m)
#pragma unroll
                    for (int n = 0; n < 2; ++n) acc[a][b][m][n] = (f32x4){zf, zf, zf, zf};
        cur = nxt; ++ui; nt = S.nt(cur); asm volatile("" : "+s"(nt)); PG8_FRAG(cur);
        if constexpr (ALIGN_EPI) { if (wr == 1) PG8_BAR; }
    }
    PG8_WAIT_V(0);
    if constexpr (!ALIGN_EPI) { if (wr == 0) PG8_BAR; }
    PG8_BAR;
#undef PG8_AOFF
#undef PG8_BOFF
#undef PG8_SA
#undef PG8_SB
#undef PG8_STAGE
#undef PG8_LDA
#undef PG8_LDB
#undef PG8_MMA
#undef PG8_CAT
#undef PG8_LO
#undef PG8_HI
#undef PG8_FRAG
#undef PG8_WAIT_V
#undef PG8_WAIT_L
#undef PG8_BAR
#undef PG8_SCHED
}

typedef f32x4 Acc[2][2][4][2];
__device__ __forceinline__ u32x4 pack8(f32x4 v0, f32x4 v1) { u32x4 w; w.x = cvt_pk(v0[0], v0[1]); w.y = cvt_pk(v0[2], v0[3]); w.z = cvt_pk(v1[0], v1[1]); w.w = cvt_pk(v1[2], v1[3]); return w; }
__device__ __forceinline__ void unpack8(u32x4 w, f32x4& v0, f32x4& v1) { v0 = (f32x4){bflo(w.x), bfhi(w.x), bflo(w.y), bfhi(w.y)}; v1 = (f32x4){bflo(w.z), bfhi(w.z), bflo(w.w), bfhi(w.w)}; }

struct EpiP {
    bf16* O;
    __device__ __forceinline__ void operator()(const Acc& acc, const Unit& u, int wr, int wc, int fr, int fq) const {
        asm volatile("" : "+v"(fr), "+v"(fq));
        const int row0 = u.pm * BM + wr * 64 + fr, col0 = u.pn * BM + wc * 32 + 8 * fq; const bool sg = u.pn >= 8;
#pragma unroll
        for (int ai = 0; ai < 2; ++ai)
#pragma unroll
            for (int m = 0; m < 4; ++m) { bf16* rowp = O + (size_t)(row0 + ai * HALF + m * 16) * NP + col0;
#pragma unroll
                for (int bj = 0; bj < 2; ++bj) { f32x4 v0 = acc[ai][bj][m][0], v1 = acc[ai][bj][m][1];
                    if (sg) {
#pragma unroll
                        for (int j = 0; j < 4; ++j) { v0[j] = sigmoidf_(v0[j]); v1[j] = sigmoidf_(v1[j]); } }
                    *(u32x4*)(rowp + bj * HALF) = pack8(v0, v1); } }
    }
};
struct EpiStore {
    bf16* O; int ldc;
    __device__ __forceinline__ void operator()(const Acc& acc, const Unit& u, int wr, int wc, int fr, int fq) const {
        asm volatile("" : "+v"(fr), "+v"(fq));
        const int row0 = u.pm * BM + wr * 64 + fr, col0 = u.pn * BM + wc * 32 + 8 * fq;
#pragma unroll
        for (int ai = 0; ai < 2; ++ai)
#pragma unroll
            for (int m = 0; m < 4; ++m) { bf16* rowp = O + (size_t)(row0 + ai * HALF + m * 16) * ldc + col0;
#pragma unroll
                for (int bj = 0; bj < 2; ++bj) *(u32x4*)(rowp + bj * HALF) = pack8(acc[ai][bj][m][0], acc[ai][bj][m][1]); }
    }
};
struct EpiQ {
    bf16* O; const float* cosT; const float* sinT;
    __device__ __forceinline__ void operator()(const Acc& acc, const Unit& u, int wr, int wc, int fr, int fq) const {
        asm volatile("" : "+v"(fr), "+v"(fq));
        const int row0 = u.pm * BM + wr * 64 + fr, col0 = u.pn * BM + wc * 32 + 8 * fq;
        const int jt = u.pm % 17; const bool lat = jt != 0; const int pos0 = (jt - 1) * 256 + wr * 64 + fr;
#pragma unroll
        for (int bj = 0; bj < 2; ++bj) { const int c = col0 + bj * HALF, d = c % 192; const bool pe = lat && d >= 128; const int i0 = (d - 128) >> 1;
#pragma unroll
            for (int ai = 0; ai < 2; ++ai)
#pragma unroll
                for (int m = 0; m < 4; ++m) { f32x4 v0 = acc[ai][bj][m][0], v1 = acc[ai][bj][m][1];
                    if (pe) { const int pos = pos0 + ai * HALF + m * 16; const f32x4 cs = *(const f32x4*)(cosT + pos * 32 + i0), sn = *(const f32x4*)(sinT + pos * 32 + i0);
                        f32x4 r0, r1;
                        r0[0] = v0[0] * cs[0] - v0[1] * sn[0]; r0[1] = v0[1] * cs[0] + v0[0] * sn[0]; r0[2] = v0[2] * cs[1] - v0[3] * sn[1]; r0[3] = v0[3] * cs[1] + v0[2] * sn[1];
                        r1[0] = v1[0] * cs[2] - v1[1] * sn[2]; r1[1] = v1[1] * cs[2] + v1[0] * sn[2]; r1[2] = v1[2] * cs[3] - v1[3] * sn[3]; r1[3] = v1[3] * cs[3] + v1[2] * sn[3];
                        v0 = r0; v1 = r1; }
                    *(u32x4*)(O + (size_t)(row0 + ai * HALF + m * 16) * NQ + c) = pack8(v0, v1); } }
    }
};
template <int K> __device__ __forceinline__ unsigned quad_bcast(unsigned x) { return (unsigned)__builtin_amdgcn_update_dpp(0, (int)x, K * 0x55, 0xf, 0xf, true); }
__device__ __forceinline__ unsigned quad_tr(unsigned w, unsigned sel) {
    const unsigned x0 = quad_bcast<0>(w), x1 = quad_bcast<1>(w), x2 = quad_bcast<2>(w), x3 = quad_bcast<3>(w);
    const unsigned lo = __builtin_amdgcn_perm(x1, x0, sel), hi = __builtin_amdgcn_perm(x3, x2, sel);
    return __builtin_amdgcn_perm(hi, lo, 0x05040100u);
}
struct EpiKV8 {
    unsigned char* K8; unsigned char* VT8;
    __device__ __forceinline__ void operator()(const Acc& acc, const Unit& u, int wr, int wc, int fr, int fq) const {
        asm volatile("" : "+v"(fr), "+v"(fq));
        const int row0 = u.pm * BM + wr * 64 + fr, b = u.pm / 17, jt = u.pm - b * 17; constexpr float SK = (float)(1 << SH_K), SV = (float)(1 << SH_V);
#pragma unroll
        for (int ai = 0; ai < 2; ++ai)
#pragma unroll
            for (int m = 0; m < 4; ++m) { const int r = row0 + ai * HALF + m * 16;
                { const f32x4 v0 = acc[ai][0][m][0] * SK, v1 = acc[ai][0][m][1] * SK; u32x2 o; o.x = pk_fp8x4(v0[0], v0[1], v0[2], v0[3]); o.y = pk_fp8x4(v1[0], v1[1], v1[2], v1[3]);
                  *(u32x2*)(K8 + (size_t)r * DM + u.pn * 128 + wc * 32 + 8 * fq) = o; }
                { const f32x4 v0 = acc[ai][1][m][0] * SV, v1 = acc[ai][1][m][1] * SV; const unsigned w0 = pk_fp8x4(v0[0], v0[1], v0[2], v0[3]), w1 = pk_fp8x4(v1[0], v1[1], v1[2], v1[3]);
                  const int qi = fr & 3; const unsigned sel = (unsigned)qi | ((unsigned)(4 + qi) << 8);
                  const unsigned t0 = quad_tr(w0, sel), t1 = quad_tr(w1, sel);
                  const int tile = jt * 4 + ai * 2 + wr, slot0 = 32 * ((fr >> 2) & 1) + 16 * (m >> 1) + 4 * (2 * (m & 1) + (fr >> 3));
                  unsigned char* vp = VT8 + ((size_t)(b * NH + u.pn) * 128 + wc * 32 + 8 * fq + qi) * RPB + tile * 64 + slot0;
                  *(unsigned*)vp = t0; *(unsigned*)(vp + (size_t)4 * RPB) = t1; } }
    }
};
struct EpiQ8 {
    unsigned char* O; const float* cosT; const float* sinT;
    __device__ __forceinline__ void operator()(const Acc& acc, const Unit& u, int wr, int wc, int fr, int fq) const {
        asm volatile("" : "+v"(fr), "+v"(fq));
        const int row0 = u.pm * BM + wr * 64 + fr, col0 = u.pn * BM + wc * 32 + 8 * fq; constexpr float SQ = QK_C * (float)(1 << SH_QC);
        const int jt = u.pm % 17; const bool lat = jt != 0; const int pos0 = (jt - 1) * 256 + wr * 64 + fr;
#pragma unroll
        for (int bj = 0; bj < 2; ++bj) { const int c = col0 + bj * HALF, d = c % 192; const bool pe = lat && d >= 128; const int i0 = (d - 128) >> 1;
#pragma unroll
            for (int ai = 0; ai < 2; ++ai)
#pragma unroll
                for (int m = 0; m < 4; ++m) { f32x4 v0 = acc[ai][bj][m][0], v1 = acc[ai][bj][m][1];
                    if (pe) { const int pos = pos0 + ai * HALF + m * 16; const f32x4 cs = *(const f32x4*)(cosT + pos * 32 + i0), sn = *(const f32x4*)(sinT + pos * 32 + i0);
                        f32x4 r0, r1;
                        r0[0] = v0[0] * cs[0] - v0[1] * sn[0]; r0[1] = v0[1] * cs[0] + v0[0] * sn[0]; r0[2] = v0[2] * cs[1] - v0[3] * sn[1]; r0[3] = v0[3] * cs[1] + v0[2] * sn[1];
                        r1[0] = v1[0] * cs[2] - v1[1] * sn[2]; r1[1] = v1[1] * cs[2] + v1[0] * sn[2]; r1[2] = v1[2] * cs[3] - v1[3] * sn[3]; r1[3] = v1[3] * cs[3] + v1[2] * sn[3];
                        v0 = r0; v1 = r1; }
                    v0 = v0 * SQ; v1 = v1 * SQ; u32x2 o; o.x = pk_fp8x4(v0[0], v0[1], v0[2], v0[3]); o.y = pk_fp8x4(v1[0], v1[1], v1[2], v1[3]);
                    *(u32x2*)(O + (size_t)(row0 + ai * HALF + m * 16) * NQ + c) = o; } }
    }
};
struct EpiPool {
    bf16* O; const bf16* P; const float* pscale;
    __device__ __forceinline__ void operator()(const Acc& acc, const Unit& u, int wr, int wc, int fr, int fq) const {
        asm volatile("" : "+v"(fr), "+v"(fq));
        const int row0 = u.pm * BM + wr * 64 + fr, col0 = u.pn * BM + wc * 32 + 8 * fq;
        u32x4 gw[2][2][4];
#pragma unroll
        for (int bj = 0; bj < 2; ++bj)
#pragma unroll
            for (int ai = 0; ai < 2; ++ai)
#pragma unroll
                for (int m = 0; m < 4; ++m) gw[bj][ai][m] = *(const u32x4*)(P + (size_t)(row0 + ai * HALF + m * 16) * NP + P_GP + col0 + bj * HALF);
#pragma unroll
        for (int bj = 0; bj < 2; ++bj) { const int c = col0 + bj * HALF; const f32x4 s0 = *(const f32x4*)(pscale + c), s1 = *(const f32x4*)(pscale + c + 4);
#pragma unroll
            for (int ai = 0; ai < 2; ++ai) {
#pragma unroll
                for (int m = 0; m < 4; ++m) { const size_t r = (size_t)(row0 + ai * HALF + m * 16); f32x4 g0, g1; unpack8(gw[bj][ai][m], g0, g1);
                    *(u32x4*)(O + r * DM + c) = pack8(acc[ai][bj][m][0] * s0 * g0, acc[ai][bj][m][1] * s1 * g1); } } }
    }
};
struct EpiTri {
#if ATT_FP8
    EpiKV8 kv; EpiQ8 q; EpiPool pool;
#else
    EpiStore kv; EpiQ q; EpiPool pool;
#endif
    __device__ __forceinline__ void operator()(const Acc& acc, const Unit& u, int wr, int wc, int fr, int fq) const {
        if (u.kind == 0) kv(acc, u, wr, wc, fr, fq); else if (u.kind == 1) q(acc, u, wr, wc, fr, fq); else pool(acc, u, wr, wc, fr, fq);
    }
};
struct EpiNull { float* sink; __device__ __forceinline__ void operator()(const Acc& acc, const Unit& u, int wr, int wc, int fr, int fq) const {
        f32x4 t = {0, 0, 0, 0};
#pragma unroll
        for (int a = 0; a < 2; ++a)
#pragma unroll
            for (int b = 0; b < 2; ++b)
#pragma unroll
                for (int m = 0; m < 4; ++m)
#pragma unroll
                    for (int n = 0; n < 2; ++n) t += acc[a][b][m][n];
        if (t[0] + t[1] + t[2] + t[3] == 1.2345e33f) *sink = t[0]; } };
struct EpiKQ8 {
    EpiKV8 kv; EpiQ8 q;
    __device__ __forceinline__ void operator()(const Acc& acc, const Unit& u, int wr, int wc, int fr, int fq) const { if (u.kind == 0) kv(acc, u, wr, wc, fr, fq); else q(acc, u, wr, wc, fr, fq); }
};
struct EpiRes {
    const Frame* F; bool first; const float* gate;
    __device__ __forceinline__ void operator()(const Acc& acc, const Unit& u, int wr, int wc, int fr, int fq) const {
        asm volatile("" : "+v"(fr), "+v"(fq));
        const int row0 = u.pm * BM + wr * 64 + fr, col0 = u.pn * BM + wc * 32 + 8 * fq; const float* gr = gate + (size_t)mod_row(u.pm * BM) * NMOD;
#pragma unroll
        for (int bj = 0; bj < 2; ++bj) { const int c = col0 + bj * HALF; const f32x4 g0 = *(const f32x4*)(gr + c), g1 = *(const f32x4*)(gr + c + 4);
            if (first) {
#pragma unroll
                for (int ai = 0; ai < 2; ++ai) { f32x4 xf[4][2];
#pragma unroll
                    for (int m = 0; m < 4; ++m) { const float* src = xin_row(*F, row0 + ai * HALF + m * 16) + c; xf[m][0] = *(const f32x4*)src; xf[m][1] = *(const f32x4*)(src + 4); }
#pragma unroll
                    for (int m = 0; m < 4; ++m) *(u32x4*)(xres_row(*F, row0 + ai * HALF + m * 16) + c) = pack8(xf[m][0] + g0 * acc[ai][bj][m][0], xf[m][1] + g1 * acc[ai][bj][m][1]);
                    asm volatile("" ::: "memory"); } }
            else { u32x4 xb[2][4];
#pragma unroll
                for (int ai = 0; ai < 2; ++ai)
#pragma unroll
                    for (int m = 0; m < 4; ++m) xb[ai][m] = *(const u32x4*)(xres_row(*F, row0 + ai * HALF + m * 16) + c);
#pragma unroll
                for (int ai = 0; ai < 2; ++ai)
#pragma unroll
                    for (int m = 0; m < 4; ++m) { f32x4 x0, x1; unpack8(xb[ai][m], x0, x1);
                        *(u32x4*)(xres_row(*F, row0 + ai * HALF + m * 16) + c) = pack8(x0 + g0 * acc[ai][bj][m][0], x1 + g1 * acc[ai][bj][m][1]); } }
            asm volatile("" ::: "memory"); }
    }
};
struct EpiUp {
    unsigned char* Act; const volatile LAS float* cwa; const volatile LAS float* cwb;
    __device__ __forceinline__ void operator()(const Acc& acc, const Unit& u, int wr, int wc, int fr, int fq) const {
        asm volatile("" : "+v"(fr), "+v"(fq));
        const int seg = u.pn >> 2, lrow0 = wr * 64 + fr, hid0 = (u.pn & 3) * 128 + wc * 16 + 4 * fq;
        float wv[2][4];
        { const LAS float* wsrc = (const LAS float*)(seg == 1 ? cwa : cwb) + u.slot * 256 + lrow0;
#pragma unroll
          for (int ai = 0; ai < 2; ++ai)
#pragma unroll
            for (int m = 0; m < 4; ++m) wv[ai][m] = seg == 0 ? 1.f : wsrc[ai * HALF + m * 16]; }
#pragma unroll
        for (int ai = 0; ai < 2; ++ai)
#pragma unroll
            for (int m = 0; m < 4; ++m) { const int lr = lrow0 + ai * HALF + m * 16; const float w = wv[ai][m];
                unsigned char* rowp = Act + (size_t)(u.arow0 + lr) * NACT + seg * 512 + hid0; const float ws_ = w * (float)(1 << SH_ACT);
#pragma unroll
                for (int bj = 0; bj < 2; ++bj) { const f32x4 g = acc[ai][bj][m][0], up = acc[ai][bj][m][1]; f32x4 a;
#pragma unroll
                    for (int j = 0; j < 4; ++j) a[j] = ws_ * g[j] * sigmoidf_(g[j]) * up[j];
                    *(unsigned*)(rowp + bj * 64) = pk_fp8x4(a[0], a[1], a[2], a[3]); } }
    }
};
struct EpiDown {
    const Frame* F; const float* gate; const volatile LAS int* cidx; bool dry;
    __device__ __forceinline__ void operator()(const Acc& acc, const Unit& u, int wr, int wc, int fr, int fq) const {
        asm volatile("" : "+v"(fr), "+v"(fq));
        const int lrow0 = wr * 64 + fr, col0 = u.pn * BM + wc * 32 + 8 * fq;
#pragma unroll
        for (int ai = 0; ai < 2; ++ai) { int tok[4]; u32x4 xb[4][2];
#pragma unroll
            for (int m = 0; m < 4; ++m) { const int lr = lrow0 + ai * HALF + m * 16; tok[m] = (lr < u.nrows && !dry) ? cidx[u.slot * 256 + lr] : -1; }
#pragma unroll
            for (int m = 0; m < 4; ++m)
#pragma unroll
                for (int bj = 0; bj < 2; ++bj) if (tok[m] >= 0) xb[m][bj] = *(const u32x4*)(xres_row(*F, tok[m]) + col0 + bj * HALF);
#pragma unroll
            for (int m = 0; m < 4; ++m) {
                if (tok[m] >= 0) { bf16* xr = xres_row(*F, tok[m]); const float* gr = gate + (size_t)mod_row(tok[m]) * NMOD;
#pragma unroll
                    for (int bj = 0; bj < 2; ++bj) { const int c = col0 + bj * HALF; const f32x4 g0 = *(const f32x4*)(gr + c), g1 = *(const f32x4*)(gr + c + 4);
                        f32x4 x0, x1; unpack8(xb[m][bj], x0, x1);
                        *(u32x4*)(xr + c) = pack8(x0 + g0 * acc[ai][bj][m][0], x1 + g1 * acc[ai][bj][m][1]); } } }
            asm volatile("" ::: "memory"); }
    }
};
}

namespace att {
constexpr int NW = 8, QBLK = 32, KVBLK = 64;
constexpr float SCALE = 0.07216878364870322f;
constexpr float THR = 8.f;
constexpr int LDQ = NQ, LDK = NKV, LDP = 64;
constexpr int SHM_V = KVBLK * 128 * 2, SHM_K = KVBLK * 128 * 2, SHM_P = KVBLK * 64 * 2;
constexpr int OFF_V = 0, OFF_K = 2 * SHM_V, OFF_P = OFF_K + 2 * SHM_K, OFF_WS = OFF_P + 2 * SHM_P;
#define KSWZ(row, colB) ((row) * 256 + ((colB) ^ (((row) & 7) << 4)))
#define PSWZ(row, colB) ((row) * 128 + ((colB) ^ (((row) & 7) << 4)))
#define SBAR() __builtin_amdgcn_sched_barrier(0)
__device__ __forceinline__ int crow(int r, int hi) { return (r & 3) + 8 * (r >> 2) + 4 * hi; }
__device__ __forceinline__ unsigned cvtpk(float lo, float hi) { unsigned r; asm volatile("v_cvt_pk_bf16_f32 %0, %1, %2" : "=v"(r) : "v"(lo), "v"(hi)); return r; }

__device__ __forceinline__ void partialSM(f32x16& p0, f32x16& p1, float& m_reg, float& mn, float& alpha) {
  constexpr float C = SCALE * 1.4426950408889634f;
  float pmax = p0[0];
#pragma unroll
  for (int r = 1; r < 16; ++r) pmax = fmaxf(pmax, p0[r]);
#pragma unroll
  for (int r = 0; r < 16; ++r) pmax = fmaxf(pmax, p1[r]);
  { auto rr = __builtin_amdgcn_permlane32_swap(__float_as_uint(pmax), __float_as_uint(pmax), false, false);
    pmax = fmaxf(__uint_as_float(rr[0]), __uint_as_float(rr[1])); }
  if (__builtin_expect(__all(pmax - m_reg <= THR / SCALE), 1)) { mn = m_reg; alpha = 1.f; }
  else { mn = fmaxf(m_reg, pmax); alpha = __builtin_amdgcn_exp2f((m_reg - mn) * C); m_reg = mn; }
  float mnC = -mn * C;
#pragma unroll
  for (int r = 0; r < 16; ++r) p0[r] = fmaf(p0[r], C, mnC);
#pragma unroll
  for (int r = 0; r < 16; ++r) p1[r] = fmaf(p1[r], C, mnC);
#pragma unroll
  for (int r = 0; r < 16; ++r) p0[r] = __builtin_amdgcn_exp2f(p0[r]);
}
__device__ __forceinline__ void finishSM(f32x16& p0, f32x16& p1, float alpha, float& l_reg, bf16x8& pa0, bf16x8& pa1, bf16x8& pa2, bf16x8& pa3) {
#pragma unroll
  for (int r = 0; r < 16; ++r) p1[r] = __builtin_amdgcn_exp2f(p1[r]);
  float ps = 0;
#pragma unroll
  for (int r = 0; r < 16; ++r) ps += p0[r];
#pragma unroll
  for (int r = 0; r < 16; ++r) ps += p1[r];
  { auto rr = __builtin_amdgcn_permlane32_swap(__float_as_uint(ps), __float_as_uint(ps), false, false);
    ps = __uint_as_float(rr[0]) + __uint_as_float(rr[1]); }
  l_reg = l_reg * alpha + ps;
#define PK4(P, BASE, OUT) do { unsigned a0 = cvtpk(P[BASE + 0], P[BASE + 1]), a1 = cvtpk(P[BASE + 2], P[BASE + 3]);   \
    unsigned b0 = cvtpk(P[BASE + 4], P[BASE + 5]), b1 = cvtpk(P[BASE + 6], P[BASE + 7]);                              \
    auto r0 = __builtin_amdgcn_permlane32_swap(a0, b0, false, false); auto r1 = __builtin_amdgcn_permlane32_swap(a1, b1, false, false); \
    u32x4 w = {r0[0], r1[0], r0[1], r1[1]}; OUT = *reinterpret_cast<bf16x8*>(&w); } while (0)
  PK4(p0, 0, pa0); PK4(p0, 8, pa1); PK4(p1, 0, pa2); PK4(p1, 8, pa3);
#undef PK4
}
__device__ __forceinline__ void qkt(f32x16& p0, f32x16& p1, const char* Ks, const char* Ps, const bf16x8* qr, int r32, int hi) {
  p0 = f32x16{}; p1 = f32x16{};
#pragma unroll
  for (int d0 = 0; d0 < 8; ++d0) { int cb = (d0 * 16 + hi * 8) * 2;
    bf16x8 b0 = *reinterpret_cast<const bf16x8*>(Ks + KSWZ(r32, cb));
    bf16x8 b1 = *reinterpret_cast<const bf16x8*>(Ks + KSWZ(32 + r32, cb));
    p0 = __builtin_amdgcn_mfma_f32_32x32x16_bf16(b0, qr[d0], p0, 0, 0, 0);
    p1 = __builtin_amdgcn_mfma_f32_32x32x16_bf16(b1, qr[d0], p1, 0, 0, 0); }
#pragma unroll
  for (int d0 = 0; d0 < 4; ++d0) { int cb = (d0 * 16 + hi * 8) * 2;
    bf16x8 b0 = *reinterpret_cast<const bf16x8*>(Ps + PSWZ(r32, cb));
    bf16x8 b1 = *reinterpret_cast<const bf16x8*>(Ps + PSWZ(32 + r32, cb));
    p0 = __builtin_amdgcn_mfma_f32_32x32x16_bf16(b0, qr[8 + d0], p0, 0, 0, 0);
    p1 = __builtin_amdgcn_mfma_f32_32x32x16_bf16(b1, qr[8 + d0], p1, 0, 0, 0); }
}
__device__ __forceinline__ int v_st(int k, int c) { const int kk = (k & ~0xC) | ((k & 4) << 1) | ((k & 8) >> 1); return ((kk >> 3) * 4 + (c >> 5)) * 512 + ((kk & 7) * 32 + (c & 31)) * 2; }
__device__ __forceinline__ int v_rd_base(int lane) { return ((lane & 3) << 3) | (((lane >> 2) & 3) << 6) | (((lane >> 4) & 1) << 5) | (((lane >> 5) & 1) << 8); }
constexpr int v_rd_off(int d0, int ks, int half) { return d0 * 512 + ks * 4096 + half * 2048; }
template <int OFF> __device__ __forceinline__ s16x4 tr_read(int vb) {
  s16x4 r; asm volatile("ds_read_b64_tr_b16 %0, %1 offset:%2" : "=&v"(r) : "v"(vb), "i"(OFF) : "memory"); return r;
}
template <int D0> __device__ __forceinline__ void pv_one(f32x16& od, int vb, bf16x8 pa0, bf16x8 pa1, bf16x8 pa2, bf16x8 pa3) {
  const s16x4 l0 = tr_read<v_rd_off(D0, 0, 0)>(vb), h0 = tr_read<v_rd_off(D0, 0, 1)>(vb), l1 = tr_read<v_rd_off(D0, 1, 0)>(vb), h1 = tr_read<v_rd_off(D0, 1, 1)>(vb);
  const s16x4 l2 = tr_read<v_rd_off(D0, 2, 0)>(vb), h2 = tr_read<v_rd_off(D0, 2, 1)>(vb), l3 = tr_read<v_rd_off(D0, 3, 0)>(vb), h3 = tr_read<v_rd_off(D0, 3, 1)>(vb);
  asm volatile("s_waitcnt lgkmcnt(0)" ::: "memory"); SBAR();
#define PK(L, H) (bf16x8){L[0], L[1], L[2], L[3], H[0], H[1], H[2], H[3]}
  od = __builtin_amdgcn_mfma_f32_32x32x16_bf16(pa0, PK(l0, h0), od, 0, 0, 0);
  od = __builtin_amdgcn_mfma_f32_32x32x16_bf16(pa1, PK(l1, h1), od, 0, 0, 0);
  od = __builtin_amdgcn_mfma_f32_32x32x16_bf16(pa2, PK(l2, h2), od, 0, 0, 0);
  od = __builtin_amdgcn_mfma_f32_32x32x16_bf16(pa3, PK(l3, h3), od, 0, 0, 0);
#undef PK
}
__device__ __forceinline__ void pv_d0(f32x16* o, int vb, bf16x8 pa0, bf16x8 pa1, bf16x8 pa2, bf16x8 pa3) {
  pv_one<0>(o[0], vb, pa0, pa1, pa2, pa3); pv_one<1>(o[1], vb, pa0, pa1, pa2, pa3); pv_one<2>(o[2], vb, pa0, pa1, pa2, pa3); pv_one<3>(o[3], vb, pa0, pa1, pa2, pa3);
}
__device__ __forceinline__ void attn_unit(const bf16* __restrict__ Qb, const bf16* __restrict__ Kh, const bf16* __restrict__ Vh, const bf16* __restrict__ Kp,
                                          bf16* Mx, const bf16* Gt, int seq, char* lds, bool dry, const int wave) {
  int tid = tid_from(wave); asm volatile("" : "+v"(tid));
  const int wid = wave, lane = tid & 63, r32 = lane & 31, hi = lane >> 5;
  char* V_lds = lds + OFF_V; char* K_lds = lds + OFF_K; char* P_lds = lds + OFF_P;
  float* ws = (float*)(lds + OFF_WS) + wid * 64; float* li_l = ws; float* al_l = ws + 32;
  float m_reg = -1e30f, l_reg = 0; f32x16 o[4] = {}; bf16x8 qr[12];
  __syncthreads();
  const bf16* Qw = Qb + (long)(wid * QBLK + r32) * LDQ + hi * 8;
#pragma unroll
  for (int d0 = 0; d0 < 12; ++d0) qr[d0] = *reinterpret_cast<const bf16x8*>(Qw + d0 * 16);
  const int sr = tid >> 4, sc = (tid & 15) * 8, vst0 = v_st(sr, sc), vst1 = v_st(32 + sr, sc);
  const int pr = tid >> 3, pc = (tid & 7) * 8;
  const int vb0 = (int)(uintptr_t)V_lds + v_rd_base(lane);
#ifndef ATT_SDEPTH
#define ATT_SDEPTH 1
#endif
  struct { bf16x8 vs0, vs1, ks0, ks1, ps; } sr_[ATT_SDEPTH];
  const unsigned off0 = (unsigned)(sr * LDK + sc) * 2u, offp = (unsigned)(pr * LDP + pc) * 2u;
#define SLOAD(i, k0) do { const char* kb_ = (const char*)Kh + (size_t)(k0) * (LDK * 2); const char* vb_ = (const char*)Vh + (size_t)(k0) * (LDK * 2); \
    sr_[i].vs0 = *(const bf16x8*)(vb_ + off0); sr_[i].vs1 = *(const bf16x8*)(vb_ + 32 * LDK * 2 + off0); \
    sr_[i].ks0 = *(const bf16x8*)(kb_ + off0); sr_[i].ks1 = *(const bf16x8*)(kb_ + 32 * LDK * 2 + off0); \
    sr_[i].ps = *(const bf16x8*)((const char*)Kp + (size_t)(k0) * (LDP * 2) + offp); } while (0)
#define SWRITE(b, i) do { *(bf16x8*)(V_lds + (b) * SHM_V + vst0) = sr_[i].vs0; *(bf16x8*)(V_lds + (b) * SHM_V + vst1) = sr_[i].vs1; int kc = sc * 2;  \
    *(bf16x8*)(K_lds + (b) * SHM_K + KSWZ(sr, kc)) = sr_[i].ks0; *(bf16x8*)(K_lds + (b) * SHM_K + KSWZ(32 + sr, kc)) = sr_[i].ks1;                    \
    *(bf16x8*)(P_lds + (b) * SHM_P + PSWZ(pr, pc * 2)) = sr_[i].ps; } while (0)
#if ATT_SDEPTH == 2
#define SWAIT() asm volatile("s_waitcnt vmcnt(5)" ::: "memory")
#else
#define SWAIT() asm volatile("s_waitcnt vmcnt(0)" ::: "memory")
#endif
#define RESC(a) do { if (__any((a) < 1.f)) { if (hi == 0) al_l[r32] = (a); asm volatile("s_waitcnt lgkmcnt(0)" ::: "memory"); \
    _Pragma("unroll") for (int d = 0; d < 4; ++d) _Pragma("unroll") for (int r = 0; r < 16; ++r) o[d][r] *= al_l[crow(r, hi)]; } } while (0)
  f32x16 pA0, pA1, pB0, pB1; float mnA, mnB, alA, alB; bf16x8 pa0, pa1, pa2, pa3; const int NT = seq / KVBLK;
  constexpr int SE = 0, SO = ATT_SDEPTH - 1;
  SLOAD(SE, 0); asm volatile("s_waitcnt vmcnt(0)" ::: "memory"); SWRITE(0, SE); __syncthreads();
  qkt(pA0, pA1, K_lds, P_lds, qr, r32, hi); partialSM(pA0, pA1, m_reg, mnA, alA);
  SLOAD(SO, KVBLK); if (ATT_SDEPTH == 2 && 2 < NT) SLOAD(SE, 2 * KVBLK);
  SWAIT(); SWRITE(1, SO); __syncthreads();
  for (int j = 1; j + 1 < NT; j += 2) {
    SBAR(); qkt(pB0, pB1, K_lds + SHM_K, P_lds + SHM_P, qr, r32, hi);
    finishSM(pA0, pA1, alA, l_reg, pa0, pa1, pa2, pa3); SBAR();
    SLOAD(SO, (j + ATT_SDEPTH) * KVBLK); SBAR();
    pv_d0(o, vb0, pa0, pa1, pa2, pa3); partialSM(pB0, pB1, m_reg, mnB, alB);
    __syncthreads(); SWAIT(); SWRITE(0, SE);
    RESC(alB); __syncthreads();
    SBAR(); qkt(pA0, pA1, K_lds, P_lds, qr, r32, hi);
    finishSM(pB0, pB1, alB, l_reg, pa0, pa1, pa2, pa3); SBAR();
    if (ATT_SDEPTH == 1 || j + 3 < NT) SLOAD(SE, (j + 1 + ATT_SDEPTH) * KVBLK); SBAR();
    pv_d0(o, vb0 + (int)SHM_V, pa0, pa1, pa2, pa3); partialSM(pA0, pA1, m_reg, mnA, alA);
    __syncthreads(); SWAIT(); SWRITE(1, SO);
    RESC(alA); __syncthreads();
  }
  SBAR(); qkt(pB0, pB1, K_lds + SHM_K, P_lds + SHM_P, qr, r32, hi);
  finishSM(pA0, pA1, alA, l_reg, pa0, pa1, pa2, pa3); SBAR();
  pv_d0(o, vb0, pa0, pa1, pa2, pa3); partialSM(pB0, pB1, m_reg, mnB, alB);
  __syncthreads(); RESC(alB);
  finishSM(pB0, pB1, alB, l_reg, pa0, pa1, pa2, pa3); SBAR();
  pv_d0(o, vb0 + (int)SHM_V, pa0, pa1, pa2, pa3);
  if (hi == 0) li_l[r32] = l_reg; asm volatile("s_waitcnt lgkmcnt(0)" ::: "memory");
  float rli[16];
#pragma unroll
  for (int r = 0; r < 16; ++r) rli[r] = __builtin_amdgcn_rcpf(li_l[crow(r, hi)]);
  __syncthreads();
  float* ep = (float*)(lds + wid * (32 * 132 * 4));
#pragma unroll
  for (int r = 0; r < 16; ++r)
#pragma unroll
    for (int d0 = 0; d0 < 4; ++d0) ep[crow(r, hi) * 132 + d0 * 32 + r32] = o[d0][r] * rli[r];
  asm volatile("s_waitcnt lgkmcnt(0)" ::: "memory");
  int lane2 = lane_now();
#pragma unroll 2
  for (int it = 0; it < 8; ++it) { const int item = it * 64 + lane2, row = item >> 4, ch = item & 15; const long orow = wid * QBLK + row;
    const f32x4 y0 = *(const f32x4*)(ep + row * 132 + ch * 8), y1 = *(const f32x4*)(ep + row * 132 + ch * 8 + 4);
    f32x4 g0, g1, m0, m1; pg8::unpack8(*(const u32x4*)(Gt + orow * NP + ch * 8), g0, g1); pg8::unpack8(*(const u32x4*)(Mx + orow * DM + ch * 8), m0, m1);
    if (!dry) *(u32x4*)(Mx + orow * DM + ch * 8) = pg8::pack8(g0 * y0 + m0, g1 * y1 + m1); }
#if PROBE_ATTN
  bf16* dbg = *(bf16* volatile*)(lds + L_MISC + 64);
#else
  bf16* dbg = nullptr;
#endif
  if (dbg) {
    const int lane3 = lane_now(), wid3 = wid; const float* ep3 = (const float*)(lds + wid3 * (32 * 132 * 4));
#pragma unroll 1
    for (int it = 0; it < 8; ++it) { const int item = it * 64 + lane3, row = item >> 4, ch = item & 15;
      const f32x4 y0 = *(const f32x4*)(ep3 + row * 132 + ch * 8), y1 = *(const f32x4*)(ep3 + row * 132 + ch * 8 + 4);
      *(u32x4*)(dbg + (long)(wid3 * QBLK + row) * 128 + ch * 8) = pg8::pack8(y0, y1); } }
#undef SLOAD
#undef SWRITE
#undef SWAIT
#undef RESC
}
}


namespace att8 {
using att::crow; using att::cvtpk;
#ifndef PROBE_ABL
#define PROBE_ABL 0
#endif
constexpr int KVBLK = 64, QBLK = 32;
constexpr float SCALE = 0.07216878364870322f;
constexpr float THR = 3.f;
constexpr int KP = 208, VP = 80;
constexpr int SHM_K = KVBLK * KP, SHM_V = 128 * VP;
constexpr int NBUF = 4;
constexpr int OFF_K = 0, OFF_V = NBUF * SHM_K, OFF_WS = OFF_V + NBUF * SHM_V, OFF_QS = OFF_WS + 2048;
#define A8_CAT(lo, hi) __builtin_shufflevector(lo, hi, 0, 1, 2, 3, 4, 5, 6, 7)
__device__ __forceinline__ i32x8 ld32(const char* p) { const i32x4 lo = *(const i32x4*)p, hi = *(const i32x4*)(p + 16); return A8_CAT(lo, hi); }
__device__ __forceinline__ void partialSM(f32x16& p0, f32x16& p1, f32x16& negm, float& alpha, const bool first, const bool abl = false) {
  if (PROBE_ABL == 2 && abl) { alpha = 1.f; return; }
  constexpr float T2 = THR * 1.4426950408889634f;
  float pmax = __builtin_fmaxf(p0[0], p1[0]);
#pragma unroll
  for (int r = 1; r < 16; ++r) pmax = __builtin_fmaxf(__builtin_fmaxf(pmax, p0[r]), p1[r]);
  { auto rr = __builtin_amdgcn_permlane32_swap(__float_as_uint(pmax), __float_as_uint(pmax), false, false);
    pmax = fmaxf(__uint_as_float(rr[0]), __uint_as_float(rr[1])); }
  const float over = pmax - (float)SH_P;
  if (__builtin_expect(!first && __all(over <= T2), 1)) { alpha = 1.f; }
  else { const float delta = first ? over : fmaxf(over, 0.f); alpha = first ? 0.f : __builtin_amdgcn_exp2f(-delta);
#pragma unroll
    for (int r = 0; r < 16; ++r) { p0[r] -= delta; p1[r] -= delta; negm[r] -= delta; } }
  if (PROBE_ABL == 1 && abl) return;
#pragma unroll
  for (int r = 0; r < 16; ++r) p0[r] = __builtin_amdgcn_exp2f(p0[r]);
}
__device__ __forceinline__ void finishSM(f32x16& p0, f32x16& p1, float& l_reg, i32x8& pa, const bool abl = false) {
  if (PROBE_ABL == 2 && abl) return;
  if (!(PROBE_ABL == 1 && abl)) {
#pragma unroll
  for (int r = 0; r < 16; ++r) p1[r] = __builtin_amdgcn_exp2f(p1[r]); }
  float ps = 0;
#pragma unroll
  for (int r = 0; r < 16; ++r) ps += p0[r];
#pragma unroll
  for (int r = 0; r < 16; ++r) ps += p1[r];
  { auto rr = __builtin_amdgcn_permlane32_swap(__float_as_uint(ps), __float_as_uint(ps), false, false);
    ps = __uint_as_float(rr[0]) + __uint_as_float(rr[1]); }
  l_reg += ps;
#pragma unroll
  for (int w = 0; w < 4; ++w) { int x = __float_as_int(p0[4 * w]);
    x = __builtin_amdgcn_cvt_pk_fp8_f32(p0[4 * w], p0[4 * w + 1], x, false); x = __builtin_amdgcn_cvt_pk_fp8_f32(p0[4 * w + 2], p0[4 * w + 3], x, true); pa[w] = x; }
#pragma unroll
  for (int w = 0; w < 4; ++w) { int x = __float_as_int(p1[4 * w]);
    x = __builtin_amdgcn_cvt_pk_fp8_f32(p1[4 * w], p1[4 * w + 1], x, false); x = __builtin_amdgcn_cvt_pk_fp8_f32(p1[4 * w + 2], p1[4 * w + 3], x, true); pa[4 + w] = x; }
}
__device__ __forceinline__ void ldk0(i32x8 (&pre)[4], const char* Ks, int r32, int hi) { pre[0] = ld32(Ks + r32 * KP + 32 * hi); pre[1] = ld32(Ks + (32 + r32) * KP + 32 * hi); pre[2] = ld32(Ks + r32 * KP + 64 + 32 * hi); pre[3] = ld32(Ks + (32 + r32) * KP + 64 + 32 * hi); }
__device__ __forceinline__ void qkt(f32x16& p0, f32x16& p1, const char* Ks, const i32x8* qf, const i32x8 (&pre)[4], const f32x16& negm, int r32, int hi, const bool abl = false) {
  if (PROBE_ABL == 5 && abl) { p0 = negm; p1 = negm; return; }
  constexpr int scK = (127 - SH_K) * 0x01010101, scQ = (127 - SH_QC) * 0x01010101;
#pragma unroll
  for (int s = 0; s < 3; ++s) { i32x8 a0, a1; if (s < 2) { a0 = pre[2 * s]; a1 = pre[2 * s + 1]; } else { a0 = ld32(Ks + r32 * KP + 64 * s + 32 * hi); a1 = ld32(Ks + (32 + r32) * KP + 64 * s + 32 * hi); }
    const i32x8 q = qf[s];
    p0 = __builtin_amdgcn_mfma_scale_f32_32x32x64_f8f6f4(a0, q, s == 0 ? negm : p0, 0, 0, 0, scK, 0, scQ);
    p1 = __builtin_amdgcn_mfma_scale_f32_32x32x64_f8f6f4(a1, q, s == 0 ? negm : p1, 0, 0, 0, scK, 0, scQ);
    if (s < 2) __builtin_amdgcn_sched_barrier(0x406); }
}
__device__ __forceinline__ void pv(f32x16* o, const char* Vs, const i32x8& pa, int r32, int hi, const bool abl = false) {
  if (PROBE_ABL == 5 && abl) return;
  constexpr int scP = (127 - SH_P) * 0x01010101, scV = (127 - SH_V) * 0x01010101;
#pragma unroll
  for (int d0 = 0; d0 < 4; ++d0) { const i32x8 b = ld32(Vs + (32 * d0 + r32) * VP + 32 * hi);
    o[d0] = __builtin_amdgcn_mfma_scale_f32_32x32x64_f8f6f4(pa, b, o[d0], 0, 0, 0, scP, 0, scV); }
}
__device__ __forceinline__ void attn_unit(const unsigned char* __restrict__ Q8, const unsigned char* __restrict__ K8, const unsigned char* __restrict__ KP8, const unsigned char* __restrict__ VT,
                                          const bf16* Mx, const bf16* Gt, unsigned char* M8, int seq, char* lds, bool dry, const int wave) {
  int tid = tid_from(wave); asm volatile("" : "+v"(tid));
  const int wid = wave, lane = tid & 63, r32 = lane & 31, hi = lane >> 5;
  char* K_lds = lds + OFF_K; char* V_lds = lds + OFF_V;
  float* ws = (float*)(lds + OFF_WS) + wid * 64; float* li_l = ws; float* al_l = ws + 32;
  float l_reg = 0; f32x16 o[4] = {}; f32x16 negm; i32x8 qf[3];
#pragma unroll
  for (int r = 0; r < 16; ++r) negm[r] = (float)SH_P;
  __syncthreads();
  char* qsp = lds + OFF_QS + wid * 6144 + lane * 16;
  { const char* qp = (const char*)Q8 + (size_t)(wid * QBLK + r32) * NQ + 32 * hi;
#pragma unroll
    for (int s = 0; s < 3; ++s) { const i32x4 lo = *(const i32x4*)(qp + 64 * s), hi4 = *(const i32x4*)(qp + 64 * s + 16); qf[s] = A8_CAT(lo, hi4); } }
  unsigned offk = (unsigned)((tid >> 3) * DM + 16 * (tid & 7)), offv = (unsigned)((tid >> 2) * RPB + 16 * (tid & 3)); int wk = (tid >> 3) * KP + 16 * (tid & 7), wv = (tid >> 2) * VP + 16 * (tid & 3);
  asm volatile("" : "+v"(offk), "+v"(offv), "+v"(wk), "+v"(wv));
#ifndef ATT8_SDEPTH
#define ATT8_SDEPTH 2
#endif
  struct { u32x4 kn, vt; u32x2 kp; } sr_[ATT8_SDEPTH];
#define A8_G(T) const __attribute__((address_space(1))) T*
#define SLOAD(i, k0) do { if (PROBE_ABL == 42 && dry) break; const char* kb_ = (const char*)K8 + (size_t)(k0) * DM; const char* pb_ = (const char*)KP8 + (size_t)(k0) * 64; const char* vb_ = (const char*)VT + (size_t)(k0); \
    asm volatile("" : "+s"(kb_), "+s"(pb_), "+s"(vb_), "+v"(offk), "+v"(offv)); \
    sr_[i].kn = *(A8_G(u32x4))((A8_G(char))kb_ + offk); { unsigned op_ = (unsigned)(tid * 8); asm volatile("" : "+v"(op_)); sr_[i].kp = *(A8_G(u32x2))((A8_G(char))pb_ + op_); } sr_[i].vt = *(A8_G(u32x4))((A8_G(char))vb_ + offv); } while (0)
#define SWRITE(b, i) do { if (PROBE_ABL == 41 && dry) break; char* kd_ = K_lds + (b) * SHM_K; *(u32x4*)(kd_ + wk) = sr_[i].kn; *(u32x2*)(kd_ + wk + 128 - 8 * (tid & 7)) = sr_[i].kp; \
    *(u32x4*)(V_lds + (b) * SHM_V + wv) = sr_[i].vt; } while (0)
#if ATT8_SDEPTH == 2
#define SWAIT() asm volatile("s_waitcnt vmcnt(3)" ::: "memory")
#else
#define SWAIT() asm volatile("s_waitcnt vmcnt(0)" ::: "memory")
#endif
#define RESC(a) do { if (__any((a) < 1.f)) { l_reg *= (a); if (hi == 0) al_l[r32] = (a); asm volatile("s_waitcnt lgkmcnt(0)" ::: "memory"); \
    _Pragma("unroll") for (int d = 0; d < 4; ++d) _Pragma("unroll") for (int r = 0; r < 16; ++r) o[d][r] *= al_l[crow(r, hi)]; } } while (0)
  f32x16 pA0, pA1, pB0, pB1; float alA, alB; i32x8 pa; const int NT = seq / KVBLK;
  constexpr int SE = 0, SO = ATT8_SDEPTH - 1;
#define TCL(t) (min((t), NT - 1) * KVBLK)
  i32x8 pre[4];
#define A8_BAR() do { asm volatile("s_waitcnt lgkmcnt(8)" ::: "memory"); __builtin_amdgcn_s_barrier(); asm volatile("" ::: "memory"); } while (0)
  if (wid >= 4) __builtin_amdgcn_s_setprio(1);
  SLOAD(SE, 0); SLOAD(SO, TCL(1)); asm volatile("s_waitcnt vmcnt(0)" ::: "memory"); SWRITE(0, SE); SWRITE(1, SO); __syncthreads();
  SLOAD(SE, TCL(2));
  ldk0(pre, K_lds, r32, hi); qkt(pA0, pA1, K_lds, qf, pre, negm, r32, hi, dry); partialSM(pA0, pA1, negm, alA, true, dry);
  SLOAD(SO, TCL(3));
  SWAIT(); SWRITE(2, SE); asm volatile("" ::: "memory"); ldk0(pre, K_lds + SHM_K, r32, hi); A8_BAR();
  for (int j = 1; j + 1 < NT; j += 2) {
    SBAR(); qkt(pB0, pB1, K_lds + (j & 3) * SHM_K, qf, pre, negm, r32, hi, dry);
    finishSM(pA0, pA1, l_reg, pa, dry); SBAR();
    SLOAD(SE, TCL(j + 3)); SBAR();
    pv(o, V_lds + ((j - 1) & 3) * SHM_V, pa, r32, hi, dry); partialSM(pB0, pB1, negm, alB, false, dry);
    SWAIT(); SWRITE((j + 2) & 3, SO); RESC(alB); asm volatile("" ::: "memory"); ldk0(pre, K_lds + ((j + 1) & 3) * SHM_K, r32, hi);
    A8_BAR();
    SBAR(); qkt(pA0, pA1, K_lds + ((j + 1) & 3) * SHM_K, qf, pre, negm, r32, hi, dry);
    finishSM(pB0, pB1, l_reg, pa, dry); SBAR();
    SLOAD(SO, TCL(j + 4)); SBAR();
    pv(o, V_lds + (j & 3) * SHM_V, pa, r32, hi, dry); partialSM(pA0, pA1, negm, alA, false, dry);
    SWAIT(); SWRITE((j + 3) & 3, SE); RESC(alA); asm volatile("" ::: "memory"); ldk0(pre, K_lds + ((j + 2) & 3) * SHM_K, r32, hi);
    A8_BAR();
  }
  SBAR(); qkt(pB0, pB1, K_lds + ((NT - 1) & 3) * SHM_K, qf, pre, negm, r32, hi, dry);
  finishSM(pA0, pA1, l_reg, pa, dry); SBAR();
  pv(o, V_lds + ((NT - 2) & 3) * SHM_V, pa, r32, hi, dry); partialSM(pB0, pB1, negm, alB, false, dry);
  RESC(alB);
  finishSM(pB0, pB1, l_reg, pa, dry); SBAR();
  pv(o, V_lds + ((NT - 1) & 3) * SHM_V, pa, r32, hi, dry);
  asm volatile("s_waitcnt vmcnt(0)" ::: "memory");
#undef TCL
#undef A8_BAR
  __builtin_amdgcn_s_setprio(0);
  const int lane2 = lane_now();
  u32x4 gq[8], mq[8];
#pragma unroll
  for (int it = 0; it < 8; ++it) { const int item = it * 64 + lane2, row = item >> 4, ch = item & 15; const long orow = wid * QBLK + row;
    gq[it] = *(const u32x4*)(Gt + orow * NP + ch * 8); mq[it] = *(const u32x4*)(Mx + orow * DM + ch * 8); }
  if (hi == 0) li_l[r32] = l_reg * (1.f / (float)(1 << SH_P)); asm volatile("s_waitcnt lgkmcnt(0)" ::: "memory");
  float rli[16];
#pragma unroll
  for (int r = 0; r < 16; ++r) rli[r] = __builtin_amdgcn_rcpf(li_l[crow(r, hi)]);
  asm volatile("s_waitcnt lgkmcnt(0)" ::: "memory"); __builtin_amdgcn_s_barrier(); asm volatile("" ::: "memory");
  float* ep = (float*)(lds + wid * (32 * 132 * 4));
#pragma unroll
  for (int r = 0; r < 16; ++r)
#pragma unroll
    for (int d0 = 0; d0 < 4; ++d0) ep[crow(r, hi) * 132 + d0 * 32 + r32] = o[d0][r] * rli[r];
  asm volatile("s_waitcnt lgkmcnt(0)" ::: "memory");
#pragma unroll
  for (int it = 0; it < 8; ++it) { const int item = it * 64 + lane2, row = item >> 4, ch = item & 15; const long orow = wid * QBLK + row;
    const f32x4 y0 = *(const f32x4*)(ep + row * 132 + ch * 8), y1 = *(const f32x4*)(ep + row * 132 + ch * 8 + 4);
    f32x4 g0, g1, m0, m1; pg8::unpack8(gq[it], g0, g1); pg8::unpack8(mq[it], m0, m1);
    constexpr float SM = (float)(1 << SH_MIX); const f32x4 z0 = (g0 * y0 + m0) * SM, z1 = (g1 * y1 + m1) * SM;
    u32x2 w; w.x = pk_fp8x4(z0[0], z0[1], z0[2], z0[3]); w.y = pk_fp8x4(z1[0], z1[1], z1[2], z1[3]);
    if (!dry) *(u32x2*)(M8 + orow * DM + ch * 8) = w; }
#if PROBE_ATTN
  { bf16* dbg = *(bf16* volatile*)(lds + L_MISC + 64);
    if (dbg) { const int lane3 = lane_now(); const float* ep3 = (const float*)(lds + wid * (32 * 132 * 4));
#pragma unroll 1
      for (int it = 0; it < 8; ++it) { const int item = it * 64 + lane3, row = item >> 4, ch = item & 15;
        const f32x4 y0 = *(const f32x4*)(ep3 + row * 132 + ch * 8), y1 = *(const f32x4*)(ep3 + row * 132 + ch * 8 + 4);
        *(u32x4*)(dbg + (long)(wid * QBLK + row) * 128 + ch * 8) = pg8::pack8(y0, y1); } } }
#endif
#undef SLOAD
#undef SWRITE
#undef SWAIT
#undef RESC
#undef A8_G
}
#undef A8_CAT
}

__device__ __forceinline__ int srcbase1(int n0) { if (n0 < 512) return n0; if (n0 < 896) return 576 + (n0 - 512); if (n0 < 960) return 512 + (n0 - 896); if (n0 < 1024) return -1; if (n0 < 2048) return 960 + (n0 - 1024); return 1984 + (n0 - 2048); }
struct ItemDesc { const float* W; const float* W2; bf16* WT; int K, srcN, kind, item, nblk, fp8sh, ksrc; };
__device__ __forceinline__ void item_load(const ItemDesc& d, int lane, f32x4 (&v)[16]) {
    const int kb = d.item / d.nblk, nb = d.item - kb * d.nblk, k0 = 64 * kb, n0 = 64 * nb;
    const int jq = lane & 15, ks = lane >> 4;
    const float* src = d.W; int sc;
    if (d.kind == 3) { src = jq < 8 ? d.W : d.W2; sc = 32 * nb + 4 * (jq & 7); }
    else { const int base = d.kind == 1 ? srcbase1(n0) : n0; sc = base < 0 ? -1 : base + 4 * jq; }
    if (k0 >= d.ksrc) sc = -1;
#pragma unroll
    for (int i = 0; i < 16; ++i) v[i] = sc >= 0 ? __builtin_nontemporal_load((const f32x4*)(src + (size_t)(k0 + 4 * i + ks) * d.srcN + sc)) : (f32x4){0.f, 0.f, 0.f, 0.f};
}
__device__ __forceinline__ void item_finish(const ItemDesc& d, int lane, LAS float* scr, const f32x4 (&v)[16]) {
    const int kb = d.item / d.nblk, nb = d.item - kb * d.nblk, k0 = 64 * kb, n0 = 64 * nb, K = d.K, kind = d.kind;
    const int jq = lane & 15, ks = lane >> 4;
#pragma unroll
    for (int i = 0; i < 16; ++i)
#pragma unroll
        for (int e = 0; e < 4; ++e) scr[(4 * jq + e) * 65 + 4 * i + ks] = v[i][e];
    LDS_WAIT(); asm volatile("" ::: "memory");
    if (d.fp8sh >= 0) {
        const int c4 = lane & 3; const float sc_ = (float)(1 << d.fp8sh); unsigned char* W8 = (unsigned char*)d.WT;
        const bool perm2f = (kind == 2) && (nb % 3 == 2);
#pragma unroll
        for (int jj = 0; jj < 4; ++jj) { const int nn = (lane >> 2) + 16 * jj; int lcol = nn;
            if (perm2f) lcol = (nn & 1) ? 32 + (nn >> 1) : (nn >> 1);
            if (kind == 3) { const int q = nn >> 3, w = nn & 7; lcol = w < 4 ? 4 * q + w : 32 + 4 * q + (w - 4); }
            const LAS float* p = scr + lcol * 65 + 16 * c4;
            u32x4 o; o.x = pk_fp8x4(p[0] * sc_, p[1] * sc_, p[2] * sc_, p[3] * sc_); o.y = pk_fp8x4(p[4] * sc_, p[5] * sc_, p[6] * sc_, p[7] * sc_);
            o.z = pk_fp8x4(p[8] * sc_, p[9] * sc_, p[10] * sc_, p[11] * sc_); o.w = pk_fp8x4(p[12] * sc_, p[13] * sc_, p[14] * sc_, p[15] * sc_);
            *(u32x4*)(W8 + (size_t)(n0 + nn) * K + k0 + 16 * c4) = o; }
        LDS_WAIT(); asm volatile("" ::: "memory"); return;
    }
    const int c = lane & 7; const bool perm2 = (kind == 2) && (nb % 3 == 2);
#pragma unroll
    for (int jj = 0; jj < 8; ++jj) { const int nn = (lane >> 3) + 8 * jj;
        int lcol = nn;
        if (perm2) lcol = (nn & 1) ? 32 + (nn >> 1) : (nn >> 1);
        if (kind == 3) { const int q = nn >> 3, w = nn & 7; lcol = w < 4 ? 4 * q + w : 32 + 4 * q + (w - 4); }
        const LAS float* p = scr + lcol * 65 + 8 * c;
        u32x4 o; o.x = cvt_pk(p[0], p[1]); o.y = cvt_pk(p[2], p[3]); o.z = cvt_pk(p[4], p[5]); o.w = cvt_pk(p[6], p[7]);
        *(u32x4*)(d.WT + (size_t)(n0 + nn) * K + k0 + 8 * c) = o; }
    LDS_WAIT(); asm volatile("" ::: "memory");
}
constexpr int IT_IN = (DM / 64) * (NP / 64), IT_KVB = (512 / 64) * (NKV / 64), IT_QB = ((ATT_FP8 ? 512 : 384) / 64) * (NQ / 64), IT_POOL1 = (256 / 64) * (512 / 64), IT_OUT = (DM / 64) * (DM / 64),
              IT_GU1 = (DM / 64) * (1024 / 64), IT_D1 = (512 / 64) * (DM / 64);
constexpr int ITO_KVB = IT_IN, ITO_QB = ITO_KVB + IT_KVB, ITO_POOL = ITO_QB + IT_QB, ITO_OUT = ITO_POOL + 4 * IT_POOL1, ITO_GU = ITO_OUT + IT_OUT, ITO_D = ITO_GU + 17 * IT_GU1, IT_LAYER = ITO_D + 17 * IT_D1;

__device__ __forceinline__ ItemDesc conv_desc(Frame& F, int it) {
    ItemDesc d; d.W2 = nullptr; d.fp8sh = -1; d.ksrc = 1 << 30;
    const int l = it / IT_LAYER; int r = it - l * IT_LAYER; char* wl = (char*)(F.ws() + WS_W + (size_t)l * LW_BYTES);
    if (r < ITO_KVB) { const int nb = r % (NP / 64);
        d.W = F.in(8) + (size_t)l * DM * IN_COLS; d.K = DM; d.srcN = IN_COLS; d.kind = 1; d.item = r; d.nblk = NP / 64;
        (void)nb; d.WT = (bf16*)(wl + LW_IN8); d.fp8sh = SH_WIN; }
    else if (r < ITO_QB) { d.W = F.in(12) + (size_t)l * 512 * NKV; d.K = 512; d.srcN = NKV; d.kind = 0; d.WT = (bf16*)(wl + LW_KVB); d.item = r - ITO_KVB; d.nblk = NKV / 64; if (ATT_FP8) d.fp8sh = SH_WKQ; }
    else if (r < ITO_POOL) { d.W = F.in(11) + (size_t)l * 384 * NQ; d.K = ATT_FP8 ? 512 : 384; d.srcN = NQ; d.kind = 2; d.WT = (bf16*)(wl + LW_QB); d.item = r - ITO_QB; d.nblk = NQ / 64; if (ATT_FP8) { d.fp8sh = SH_WKQ; d.ksrc = 384; } }
    else if (r < ITO_OUT) { r -= ITO_POOL; const int g = r / IT_POOL1; d.W = F.in(13) + (size_t)(l * 4 + g) * 256 * 512; d.K = 256; d.srcN = 512; d.kind = 0; d.WT = (bf16*)(wl + LW_POOL + (size_t)g * 512 * 256); d.fp8sh = SH_WPOOL; d.item = r - g * IT_POOL1; d.nblk = 512 / 64; }
    else if (r < ITO_GU) { d.W = F.in(15) + (size_t)l * DM * DM; d.K = DM; d.srcN = DM; d.kind = 0; d.WT = (bf16*)(wl + LW_OUT); d.item = r - ITO_OUT; d.nblk = DM / 64; if (ATT_FP8) d.fp8sh = SH_WOUT; }
    else if (r < ITO_D) { r -= ITO_GU; const int e = r / IT_GU1;
        d.W = e < 16 ? F.in(18) + (size_t)(l * 16 + e) * DM * 512 : F.in(21) + (size_t)l * DM * 512; d.W2 = e < 16 ? F.in(19) + (size_t)(l * 16 + e) * DM * 512 : F.in(22) + (size_t)l * DM * 512;
        d.K = DM; d.srcN = 512; d.kind = 3; d.WT = (bf16*)(wl + LW_GU + (size_t)e * 1024 * DM); d.item = r - e * IT_GU1; d.nblk = 1024 / 64; d.fp8sh = SH_WGU; }
    else { r -= ITO_D; const int e = r / IT_D1;
        d.W = e < 16 ? F.in(20) + (size_t)(l * 16 + e) * 512 * DM : F.in(23) + (size_t)l * 512 * DM;
        d.K = 512; d.srcN = DM; d.kind = 0; d.WT = (bf16*)(wl + LW_D + (size_t)e * DM * 512); d.item = r - e * IT_D1; d.nblk = DM / 64; d.fp8sh = SH_WD; }
    return d;
}
__device__ __forceinline__ void conv_pair(Frame& F, int itA, int itB, bool hasB) {
    LAS float* scr = (LAS float*)(F.lds + F.wave * 16640);
    const ItemDesc dA = conv_desc(F, itA), dB = conv_desc(F, hasB ? itB : itA);
    f32x4 va[16], vb[16];
    item_load(dA, F.lane, va); if (hasB) item_load(dB, F.lane, vb);
    item_finish(dA, F.lane, scr, va); if (hasB) item_finish(dB, F.lane, scr, vb);
}
__device__ __forceinline__ void conv_queue(Frame& F, unsigned* q, int lo, int hi) {
    for (;;) {
        int base = 0; if (F.lane == 0) base = (int)__hip_atomic_fetch_add(q, 4u, __ATOMIC_RELAXED, __HIP_MEMORY_SCOPE_AGENT);
        base = __builtin_amdgcn_readfirstlane(base) + lo; if (base >= hi) break;
        conv_pair(F, base, base + 1, base + 1 < hi); if (base + 2 < hi) conv_pair(F, base + 2, base + 3, base + 3 < hi);
    }
}
__device__ __forceinline__ void p0_prologue(Frame& F) {
    {
        LAS float* sil = (LAS float*)F.lds;
        LAS float* red = (LAS float*)(F.lds + 40960);
        for (int q = F.tid; q < 5 * DM; q += 512) { const int i = q / DM, k = q - i * DM; const float v = i < 4 ? F.in(1)[i * DM + k] : F.in(3)[k]; sil[q] = v * sigmoidf_(v); }
        __syncthreads();
        const int tx = F.tid & 31, ty = F.tid >> 5;
        for (int it = F.vcu; it < 2 * 96; it += F.G) {
            const int l = it / 96, c0 = (it - l * 96) * 128;
            const float* wp = F.in(4) + (size_t)l * DM * NMOD + c0 + 4 * tx;
            f32x4 a0 = {0, 0, 0, 0}, a1 = a0, a2 = a0, a3 = a0, a4 = a0;
#pragma unroll 8
            for (int r = ty; r < DM; r += 16) { const f32x4 w = *(const f32x4*)(wp + (size_t)r * NMOD);
                a0 += sil[r] * w; a1 += sil[DM + r] * w; a2 += sil[2 * DM + r] * w; a3 += sil[3 * DM + r] * w; a4 += sil[4 * DM + r] * w; }
            LAS f32x4* rp = (LAS f32x4*)red + (ty * 5) * 32 + tx;
            rp[0] = a0; rp[32] = a1; rp[64] = a2; rp[96] = a3; rp[128] = a4;
            __syncthreads();
            if (F.tid < 160) { const int i = F.tid >> 5; f32x4 s = *(const f32x4*)(F.in(5) + (size_t)l * NMOD + c0 + 4 * tx);
#pragma unroll
                for (int y = 0; y < 16; ++y) s += ((LAS f32x4*)red)[(y * 5 + i) * 32 + tx];
                *(f32x4*)(F.mod() + ((size_t)l * 5 + i) * NMOD + c0 + 4 * tx) = s; }
            __syncthreads();
        }
    }
    for (int q = F.vcu * 512 + F.tid; q < SEQ * 32; q += F.G * 512) { const int pos = q >> 5, i = q & 31;
        const float inv = __builtin_amdgcn_exp2f(-(float)(i & 15) * 0.830482023721841f);
        const float ang = (float)(i < 16 ? (pos >> 6) : (pos & 63)) * inv; const float rev = ang * 0.15915494309189535f; const float fr = rev - floorf(rev);
        F.cosT()[q] = __builtin_amdgcn_cosf(fr); F.sinT()[q] = __builtin_amdgcn_sinf(fr); }
    const int gw = F.vcu * NWAVES + F.wave, NGW = F.G * NWAVES;
    for (int it = gw; it < ITO_GU; it += 2 * NGW) conv_pair(F, it, it + NGW, it + NGW < ITO_GU);
}
__device__ __forceinline__ void t1_phase(Frame& F, int l) {
    const int gw = F.vcu * NWAVES + F.wave, NGW = F.G * NWAVES, lane = F.lane;
    const float* gn = F.in(6) + (size_t)l * DM;
    const int r_begin = (int)(((long)gw * T) / NGW), r_end = (int)(((long)(gw + 1) * T) / NGW);
    f32x4 cA[8], cB[8]; int cur = -1;
    for (int r0 = r_begin; r0 < r_end; r0 += 2) {
        f32x4 v[2][8];
#pragma unroll
        for (int u = 0; u < 2; ++u) { const int r = r0 + u;
            if (r < r_end) {
                if (l == 0) { const float* xr = xin_row(F, r);
#pragma unroll
                    for (int j = 0; j < 8; ++j) v[u][j] = *(const f32x4*)(xr + 256 * j + 4 * lane); }
                else { const bf16* xr = xres_row(F, r);
#pragma unroll
                    for (int j = 0; j < 8; ++j) v[u][j] = ld4bf(xr + 256 * j + 4 * lane); } } }
#pragma unroll
        for (int u = 0; u < 2; ++u) { const int r = r0 + u;
            if (r < r_end) { const int mr = mod_row(r);
                if (mr != cur) { cur = mr; const float* md = F.mod() + ((size_t)l * 5 + mr) * NMOD;
#pragma unroll
                    for (int j = 0; j < 8; ++j) { const int c = 256 * j + 4 * lane; cA[j] = *(const f32x4*)(gn + c) * (1.f + *(const f32x4*)(md + DM + c)); cB[j] = *(const f32x4*)(md + c); } }
                float ss = 0.f;
#pragma unroll
                for (int j = 0; j < 8; ++j) ss += (v[u][j][0] * v[u][j][0] + v[u][j][1] * v[u][j][1]) + (v[u][j][2] * v[u][j][2] + v[u][j][3] * v[u][j][3]);
                if (l == 0) { bf16* xb = xres_row(F, r);
#pragma unroll
                    for (int j = 0; j < 8; ++j) { u32x2 o; o.x = cvt_pk(v[u][j][0], v[u][j][1]); o.y = cvt_pk(v[u][j][2], v[u][j][3]); *(u32x2*)(xb + 256 * j + 4 * lane) = o; } }
                const float rinv = rsqrtf(wave_sum(ss) * (1.f / DM) + EPS);
                unsigned char* orow8 = (unsigned char*)F.Z() + (size_t)r * DM;
#pragma unroll
                for (int j = 0; j < 8; ++j) { const int c = 256 * j + 4 * lane;
                    const f32x4 y = (v[u][j] * rinv) * cA[j] + cB[j];
                    constexpr float S8 = (float)(1 << SH_H); *(unsigned*)(orow8 + c) = pk_fp8x4(y[0] * S8, y[1] * S8, y[2] * S8, y[3] * S8); } } }
    }
}
__device__ __forceinline__ void t2_phase(Frame& F, int l, bool dry) {
    const bool lastl = (l == DEPTH - 1);
    const int gw = F.vcu * NWAVES + F.wave, NGW = F.G * NWAVES, lane = F.lane;
    const float* gkv = F.in(10) + (size_t)l * 512; const float* gq = F.in(9) + (size_t)l * 384;
    const int r_begin = (int)(((long)gw * T) / NGW), r_end = (int)(((long)(gw + 1) * T) / NGW);
    for (int r0 = r_begin; r0 < r_end;) {
        const int b = r0 / RPB, j0 = r0 - b * RPB; const bool isctx = j0 < CTX;
        const int seg0 = b * RPB + (isctx ? 0 : CTX), n = isctx ? CTX : SEQ, t0 = isctx ? j0 : j0 - CTX;
        int g = r_end - r0; g = g < 4 ? g : 4; g = g < n - t0 ? g : n - t0;
        u32x4 kvw[4], qw[4]; float xa[4], xb[4], csv[4], snv[4];
        const bool qact = lane < 48, needq = !(lastl && isctx);
#pragma unroll
        for (int i = 0; i < 4; ++i) { const int ii = i < g ? i : g - 1, r = r0 + ii, j = j0 + ii; const bf16* prow = F.P() + (size_t)r * NP;
            kvw[i] = *(const u32x4*)(prow + lane * 8);
            qw[i] = (u32x4){0u, 0u, 0u, 0u}; if (needq && qact) qw[i] = *(const u32x4*)(prow + P_Q + lane * 8);
            xa[i] = 0.f; xb[i] = 0.f; csv[i] = 1.f; snv[i] = 0.f;
            if (lane < 32) { xa[i] = bf2f(prow[P_KPE + lane]); xb[i] = bf2f(prow[P_KPE + 32 + lane]);
                if (!isctx) { const int pos = j - CTX; csv[i] = F.cosT()[pos * 32 + lane]; snv[i] = F.sinT()[pos * 32 + lane]; } } }
        const f32x4 gk0 = *(const f32x4*)(gkv + lane * 8), gk1 = *(const f32x4*)(gkv + lane * 8 + 4);
        f32x4 gq0 = {0, 0, 0, 0}, gq1 = gq0; if (qact) { gq0 = *(const f32x4*)(gq + lane * 8); gq1 = *(const f32x4*)(gq + lane * 8 + 4); }
#pragma unroll
        for (int i = 0; i < 4; ++i) { if (i >= g) break; const int r = r0 + i; bf16* prow = F.P() + (size_t)r * NP;
            {
                f32x4 v0, v1; pg8::unpack8(kvw[i], v0, v1);
                float ss = (v0[0] * v0[0] + v0[1] * v0[1]) + (v0[2] * v0[2] + v0[3] * v0[3]) + (v1[0] * v1[0] + v1[1] * v1[1]) + (v1[2] * v1[2] + v1[3] * v1[3]);
                const float rinv = rsqrtf(wave_sum(ss) * (1.f / 512) + EPS);
#if ATT_FP8
                if (!dry) { const f32x4 a0 = v0 * rinv * gk0 * (float)(1 << SH_LAT), a1 = v1 * rinv * gk1 * (float)(1 << SH_LAT); u32x2 o; o.x = pk_fp8x4(a0[0], a0[1], a0[2], a0[3]); o.y = pk_fp8x4(a1[0], a1[1], a1[2], a1[3]);
                    *(u32x2*)((unsigned char*)prow + lane * 8) = o; }
#else
                if (!dry) *(u32x4*)(prow + lane * 8) = pg8::pack8(v0 * rinv * gk0, v1 * rinv * gk1);
#endif
            }
            if (lane < 32) {
                const float x1 = xa[i] * csv[i] - xb[i] * snv[i], x2 = xb[i] * csv[i] + xa[i] * snv[i];
#if ATT_FP8
                { constexpr float SKp = (float)(1 << SH_K); const unsigned w = pk_fp8x4(x1 * SKp, x2 * SKp, 0.f, 0.f); ((unsigned short*)(F.KPE8() + (size_t)r * 64))[lane] = (unsigned short)w; }
#else
                ((unsigned*)(F.KPE() + (size_t)r * 64))[lane] = cvt_pk(x1, x2);
#endif
            }
            if (needq) {
                f32x4 v0, v1; pg8::unpack8(qw[i], v0, v1);
                float ss = (v0[0] * v0[0] + v0[1] * v0[1]) + (v0[2] * v0[2] + v0[3] * v0[3]) + (v1[0] * v1[0] + v1[1] * v1[1]) + (v1[2] * v1[2] + v1[3] * v1[3]);
                const float rinv = rsqrtf(wave_sum(ss) * (1.f / 384) + EPS);
#if ATT_FP8
                if (!dry) { u32x2 o; o.x = 0u; o.y = 0u;
                    if (qact) { const f32x4 a0 = v0 * rinv * gq0 * (float)(1 << SH_LAT), a1 = v1 * rinv * gq1 * (float)(1 << SH_LAT);
                        o.x = pk_fp8x4(a0[0], a0[1], a0[2], a0[3]); o.y = pk_fp8x4(a1[0], a1[1], a1[2], a1[3]); }
                    *(u32x2*)((unsigned char*)prow + P_Q * 2 + lane * 8) = o; }
#else
                if (qact && !dry) *(u32x4*)(prow + P_Q + lane * 8) = pg8::pack8(v0 * rinv * gq0, v1 * rinv * gq1);
#endif
            }
        }
        if (!(lastl && isctx)) {
            {
                const int ch = lane, half = 1 << (ch >> 5); const bf16* pc = F.P() + (size_t)seg0 * NP + P_POOL + ch * 8;
                u32x4 w[7];
#pragma unroll
                for (int k = 0; k < 7; ++k) { int q = t0 - 2 + k; q = q < 0 ? 0 : (q >= n ? n - 1 : q); w[k] = *(const u32x4*)(pc + (size_t)q * NP); }
                f32x4 s0[4], s1[4], u0[4], u1[4];
#pragma unroll
                for (int i = 0; i < 4; ++i) { s0[i] = (f32x4){0, 0, 0, 0}; s1[i] = s0[i]; u0[i] = s0[i]; u1[i] = s0[i]; }
#pragma unroll
                for (int k = 0; k < 7; ++k) { const int q = t0 - 2 + k; f32x4 a0, a1; pg8::unpack8(w[k], a0, a1);
#pragma unroll
                    for (int i = 0; i < 4; ++i) { if (k < i || k > i + 3) continue; const int t = t0 + i, lo = t - half < 0 ? 0 : t - half, hi = t + half > n ? n : t + half;
                        const float m = (q >= lo && q < hi) ? 1.f : 0.f; s0[i] += a0 * m; s1[i] += a1 * m; if (k == i + 2) { u0[i] = a0; u1[i] = a1; } } }
#pragma unroll
                for (int i = 0; i < 4; ++i) if (i < g) { const int t = t0 + i, lo = t - half < 0 ? 0 : t - half, hi = t + half > n ? n : t + half; const float rc = 1.f / (float)(hi - lo);
                    { constexpr float SZ = (float)(1 << SH_Z); const f32x4 z0 = (s0[i] * rc - u0[i]) * SZ, z1 = (s1[i] * rc - u1[i]) * SZ; u32x2 o; o.x = pk_fp8x4(z0[0], z0[1], z0[2], z0[3]); o.y = pk_fp8x4(z1[0], z1[1], z1[2], z1[3]);
                      *(u32x2*)((unsigned char*)F.Z() + (size_t)(r0 + i) * NZ + ch * 8) = o; } } }
            {
                const int ch = lane + 64, half = 1 << (ch >> 5); const bf16* pc = F.P() + (size_t)seg0 * NP + P_POOL + ch * 8;
                u32x4 w[19];
#pragma unroll
                for (int k = 0; k < 19; ++k) { int q = t0 - 8 + k; q = q < 0 ? 0 : (q >= n ? n - 1 : q); w[k] = *(const u32x4*)(pc + (size_t)q * NP); }
                f32x4 s0[4], s1[4], u0[4], u1[4];
#pragma unroll
                for (int i = 0; i < 4; ++i) { s0[i] = (f32x4){0, 0, 0, 0}; s1[i] = s0[i]; u0[i] = s0[i]; u1[i] = s0[i]; }
#pragma unroll
                for (int k = 0; k < 19; ++k) { const int q = t0 - 8 + k; f32x4 a0, a1; pg8::unpack8(w[k], a0, a1);
#pragma unroll
                    for (int i = 0; i < 4; ++i) { if (k < i || k > i + 15) continue; const int t = t0 + i, lo = t - half < 0 ? 0 : t - half, hi = t + half > n ? n : t + half;
                        const float m = (q >= lo && q < hi) ? 1.f : 0.f; s0[i] += a0 * m; s1[i] += a1 * m; if (k == i + 8) { u0[i] = a0; u1[i] = a1; } } }
#pragma unroll
                for (int i = 0; i < 4; ++i) if (i < g) { const int t = t0 + i, lo = t - half < 0 ? 0 : t - half, hi = t + half > n ? n : t + half; const float rc = 1.f / (float)(hi - lo);
                    { constexpr float SZ = (float)(1 << SH_Z); const f32x4 z0 = (s0[i] * rc - u0[i]) * SZ, z1 = (s1[i] * rc - u1[i]) * SZ; u32x2 o; o.x = pk_fp8x4(z0[0], z0[1], z0[2], z0[3]); o.y = pk_fp8x4(z1[0], z1[1], z1[2], z1[3]);
                      *(u32x2*)((unsigned char*)F.Z() + (size_t)(r0 + i) * NZ + ch * 8) = o; } } }
        }
        r0 += g;
    }
}
template <int CTRL> __device__ __forceinline__ float dpp_sel_add(float a, float b, bool hi) {
    const float keep = hi ? b : a, send = hi ? a : b; return keep + dppf<CTRL>(send);
}
__device__ __forceinline__ void t3_phase(Frame& F, int l, bool dry) {
    const bool lastl = (l == DEPTH - 1);
    LAS float* wrT = (LAS float*)F.lds;
    volatile LAS float* lgt = (volatile LAS float*)(F.ldsx + L_CIDX);
    volatile LAS int* rowid = (volatile LAS int*)(F.ldsx + L_CIDX + 80 * 64);
    volatile LAS int* pcnt = (volatile LAS int*)(F.ldsx + L_TAB);
    {
        f32x4 w4[16]; const f32x4* wsrc = (const f32x4*)F.in(16);
#pragma unroll
        for (int i = 0; i < 16; ++i) w4[i] = wsrc[F.tid + 512 * i];
#pragma unroll
        for (int i = 0; i < 16; ++i) { const int q4 = F.tid + 512 * i, k = q4 >> 2, e0 = (q4 & 3) * 4;
#pragma unroll
            for (int e = 0; e < 4; ++e) wrT[(e0 + e) * DM + k] = w4[i][e]; }
    }
    if (F.tid < 80) rowid[F.tid] = -1;
    if (F.tid < 64) pcnt[F.tid] = 0;
    __syncthreads();
    const int gw = F.vcu * NWAVES + F.wave, NGW = F.G * NWAVES, lane = F.lane;
    const float* gn = F.in(7) + (size_t)l * DM;
    const int nidx = lastl ? NBATCH * SEQ : T;
    const int i_begin = (int)(((long)gw * nidx) / NGW), i_end = (int)(((long)(gw + 1) * nidx) / NGW);
    f32x4 cA[8], cB[8]; int cur = -1;
    int it = 0;
    u32x2 raw[2][8];
#define T3_ROW(idx) (lastl ? ((idx) >> 12) * RPB + CTX + ((idx) & 4095) : (idx))
#define T3_FETCH(i0_) do { _Pragma("unroll") for (int u = 0; u < 2; ++u) { int idx = (i0_) + u; if (idx >= i_end) idx = (i0_); const bf16* xr = xres_row(F, T3_ROW(idx)); \
        _Pragma("unroll") for (int jj = 0; jj < 8; ++jj) raw[u][jj] = *(const u32x2*)(xr + 256 * jj + 4 * lane); } } while (0)
    if (i_begin < i_end) T3_FETCH(i_begin);
    for (int i0 = i_begin; i0 < i_end; i0 += 2, ++it) {
        int rr[2]; bool ok[2]; f32x4 v[2][8];
#pragma unroll
        for (int u = 0; u < 2; ++u) { int idx = i0 + u; ok[u] = idx < i_end; if (!ok[u]) idx = i0; rr[u] = T3_ROW(idx);
#pragma unroll
            for (int jj = 0; jj < 8; ++jj) { const u32x2 w = raw[u][jj]; v[u][jj] = (f32x4){bflo(w.x), bfhi(w.x), bflo(w.y), bfhi(w.y)}; } }
        if (i0 + 2 < i_end) T3_FETCH(i0 + 2);
#pragma unroll
        for (int u = 0; u < 2; ++u) { const int r = rr[u]; float ss = 0.f; const int mr = mod_row(r);
            if (mr != cur) { cur = mr; const float* md = F.mod() + ((size_t)l * 5 + mr) * NMOD + 3 * DM;
#pragma unroll
                for (int jj = 0; jj < 8; ++jj) { const int c = 256 * jj + 4 * lane; cA[jj] = *(const f32x4*)(gn + c) * (1.f + *(const f32x4*)(md + DM + c)); cB[jj] = *(const f32x4*)(md + c); } }
#pragma unroll
            for (int jj = 0; jj < 8; ++jj) ss += (v[u][jj][0] * v[u][jj][0] + v[u][jj][1] * v[u][jj][1]) + (v[u][jj][2] * v[u][jj][2] + v[u][jj][3] * v[u][jj][3]);
            const float rinv = rsqrtf(wave_sum(ss) * (1.f / DM) + EPS);
            unsigned char* orow = (unsigned char*)F.HM() + (size_t)r * DM;
#pragma unroll
            for (int jj = 0; jj < 8; ++jj) { const int c = 256 * jj + 4 * lane;
                v[u][jj] = (v[u][jj] * rinv) * cA[jj] + cB[jj]; constexpr float S2 = (float)(1 << SH_H2);
                if (ok[u]) *(unsigned*)(orow + c) = pk_fp8x4(v[u][jj][0] * S2, v[u][jj][1] * S2, v[u][jj][2] * S2, v[u][jj][3] * S2); } }
        float s[32];
#define T3_FMAC(acc, a, b) asm("v_fmac_f32 %0, %1, %2" : "+v"(acc) : "v"(a), "v"(b))
#pragma unroll
        for (int e = 0; e < 16; ++e) { float a0 = 0.f, a1 = 0.f, b0 = 0.f, b1 = 0.f;
#pragma unroll
            for (int jj = 0; jj < 8; ++jj) { const f32x4 w = *(const LAS f32x4*)(wrT + e * DM + 256 * jj + 4 * lane);
                T3_FMAC(a0, v[0][jj][0], w[0]); T3_FMAC(a1, v[0][jj][1], w[1]); T3_FMAC(a0, v[0][jj][2], w[2]); T3_FMAC(a1, v[0][jj][3], w[3]);
                T3_FMAC(b0, v[1][jj][0], w[0]); T3_FMAC(b1, v[1][jj][1], w[1]); T3_FMAC(b0, v[1][jj][2], w[2]); T3_FMAC(b1, v[1][jj][3], w[3]); }
            s[e] = a0 + a1; s[16 + e] = b0 + b1; }
#undef T3_FMAC
#pragma unroll
        for (int i = 0; i < 16; ++i) { auto q = __builtin_amdgcn_permlane32_swap(__float_as_uint(s[i]), __float_as_uint(s[i + 16]), false, false); s[i] = __uint_as_float(q[0]) + __uint_as_float(q[1]); }
#pragma unroll
        for (int i = 0; i < 8; ++i) { auto q = __builtin_amdgcn_permlane16_swap(__float_as_uint(s[i]), __float_as_uint(s[i + 8]), false, false); s[i] = __uint_as_float(q[0]) + __uint_as_float(q[1]); }
#pragma unroll
        for (int i = 0; i < 4; ++i) s[i] = dpp_sel_add<0x128>(s[i], s[i + 4], (lane & 8) != 0);
#pragma unroll
        for (int i = 0; i < 2; ++i) s[i] = dpp_sel_add<0x141>(s[i], s[i + 2], (lane & 4) != 0);
        s[0] = dpp_sel_add<0x4E>(s[0], s[1], (lane & 2) != 0);
        s[0] += dppf<0xB1>(s[0]);
        const int u = lane >> 5, slot = (F.wave * 5 + it) * 2 + u;
        if ((lane & 1) == 0) lgt[slot * 16 + ((lane >> 1) & 15)] = s[0];
        if ((lane & 31) == 0 && (u == 0 ? ok[0] : ok[1])) rowid[slot] = u == 0 ? rr[0] : rr[1];
    }
#undef T3_FETCH
#undef T3_ROW
    __syncthreads();
    int pair = -1, rank = 0, myrow = -1; float wa = 0.f, wb = 0.f;
    if (F.tid < 80 && !dry) { myrow = rowid[F.tid];
      if (myrow >= 0) {
        float sc_[16], sel[16];
#pragma unroll
        for (int e = 0; e < 16; ++e) { sc_[e] = 1.f / (1.f + expf(-lgt[F.tid * 16 + e])); sel[e] = sc_[e] + F.in(17)[e]; }
        int bg = 0; float bgs = -1e30f;
#pragma unroll
        for (int g = 0; g < 4; ++g) { float m1 = -1e30f, m2 = -1e30f;
#pragma unroll
            for (int k = 0; k < 4; ++k) { const float x = sel[4 * g + k]; if (x > m1) { m2 = m1; m1 = x; } else if (x > m2) m2 = x; }
            const float gs = m1 + m2; if (gs > bgs) { bgs = gs; bg = g; } }
        float s4[4], q4[4];
#pragma unroll
        for (int k = 0; k < 4; ++k) { s4[k] = bg == 0 ? sel[k] : (bg == 1 ? sel[4 + k] : (bg == 2 ? sel[8 + k] : sel[12 + k])); q4[k] = bg == 0 ? sc_[k] : (bg == 1 ? sc_[4 + k] : (bg == 2 ? sc_[8 + k] : sc_[12 + k])); }
        int i1 = 0; float m1 = s4[0];
#pragma unroll
        for (int k = 1; k < 4; ++k) if (s4[k] > m1) { m1 = s4[k]; i1 = k; }
        int i2 = -1; float m2 = -1e30f;
#pragma unroll
        for (int k = 0; k < 4; ++k) if (k != i1 && s4[k] > m2) { m2 = s4[k]; i2 = k; }
        const float w1 = i1 == 0 ? q4[0] : (i1 == 1 ? q4[1] : (i1 == 2 ? q4[2] : q4[3])), w2 = i2 == 0 ? q4[0] : (i2 == 1 ? q4[1] : (i2 == 2 ? q4[2] : q4[3]));
        const float ws_ = 1.f / (w1 + w2);
        const int a = i1 < i2 ? i1 : i2, bb = i1 < i2 ? i2 : i1; wa = (i1 < i2 ? w1 : w2) * ws_; wb = (i1 < i2 ? w2 : w1) * ws_;
        const int pidx = a == 0 ? bb - 1 : (a == 1 ? bb + 1 : 5); pair = bg * 6 + pidx;
        rank = __hip_atomic_fetch_add((LAS int*)(pcnt + pair), 1, __ATOMIC_RELAXED, __HIP_MEMORY_SCOPE_WORKGROUP);
      } }
    __syncthreads();
    if (F.tid < NPAIR) { const int c = pcnt[F.tid];
        pcnt[32 + F.tid] = c ? (int)__hip_atomic_fetch_add(F.ctl() + CW_CNT + (l * NPAIR + F.tid) * 64, (unsigned)c, __ATOMIC_RELAXED, __HIP_MEMORY_SCOPE_AGENT) : 0; }
    __syncthreads();
    if (pair >= 0) { const size_t dst = (size_t)pair * T + pcnt[32 + pair] + rank; F.ltok()[dst] = myrow; F.lwa()[dst] = wa; F.lwb()[dst] = wb; }
    __syncthreads();
}
__device__ __forceinline__ void moe_setup(Frame& F, int l, int nN, const bool have_counts = false) {
    volatile LAS int* tab = (volatile LAS int*)(F.ldsx + L_TAB);
    volatile LAS int* cidx = (volatile LAS int*)(F.ldsx + L_CIDX); volatile LAS float* cwa = (volatile LAS float*)(F.ldsx + L_CWA); volatile LAS float* cwb = (volatile LAS float*)(F.ldsx + L_CWB);
    LAS int* ud = (LAS int*)(F.ldsx + L_TAB) + 64;
    if (!have_counts) {
        __syncthreads();
        if (F.tid < NPAIR) tab[F.tid] = (int)__hip_atomic_load(F.ctl() + CW_CNT + (l * NPAIR + F.tid) * 64, __ATOMIC_RELAXED, __HIP_MEMORY_SCOPE_AGENT);
        __syncthreads();
    }
    if (F.tid < MAXU) {
        int cnt[NPAIR];
#pragma unroll
        for (int q = 0; q < NPAIR / 4; ++q) { const i32x4 w = *(const LAS i32x4*)((const LAS int*)tab + 4 * q); cnt[4 * q] = w[0]; cnt[4 * q + 1] = w[1]; cnt[4 * q + 2] = w[2]; cnt[4 * q + 3] = w[3]; }
        const int L = F.tid * F.G + F.bx, mt = L / nN, pn = L - mt * nN;
        int st = 0, p = 0, pbase = 0, pcnt = cnt[0];
#pragma unroll
        for (int q = 0; q < NPAIR; ++q) { if (st <= mt) { p = q; pbase = st; pcnt = cnt[q]; } if (F.tid == 0) tab[24 + q] = st; st += (cnt[q] + 255) >> 8; }
        if (F.tid == 0) tab[24 + NPAIR] = st;
        const int pm = mt - pbase, rem = pcnt - pm * 256, g = p / 6, x = p - g * 6; const int ea = x < 3 ? 0 : (x < 5 ? 1 : 2), eb = x < 3 ? x + 1 : (x < 5 ? x - 1 : 3);
        LAS int* d = ud + 8 * F.tid;
        d[0] = mt < st ? 1 : 0; d[1] = pn; d[2] = p; d[3] = pm; d[4] = rem < 256 ? rem : 256; d[5] = mt * 256; d[6] = 4 * g + ea; d[7] = 4 * g + eb;
    }
    __syncthreads();
    {
        int tok[4]; float wa[4], wb[4];
#pragma unroll
        for (int k4 = 0; k4 < 4; ++k4) { const int q = F.tid + 512 * k4, i = q >> 8, row = q & 255; tok[k4] = 0; wa[k4] = 0.f; wb[k4] = 0.f;
            const i32x4 da = *(const LAS i32x4*)(ud + 8 * i); const int nr = ud[8 * i + 4];
            if (da[0] && row < nr) { const size_t s = (size_t)da[2] * T + da[3] * 256 + row; tok[k4] = F.ltok()[s]; wa[k4] = F.lwa()[s]; wb[k4] = F.lwb()[s]; } }
#pragma unroll
        for (int k4 = 0; k4 < 4; ++k4) { const int q = F.tid + 512 * k4; cidx[q] = tok[k4]; cwa[q] = wa[k4]; cwb[q] = wb[k4]; } }
    __syncthreads();
}
__device__ __forceinline__ void final_phase(Frame& F) {
    const int gw = F.vcu * NWAVES + F.wave, NGW = F.G * NWAVES, lane = F.lane; const float* gn = F.in(24);
    const int r_begin = (int)(((long)gw * (NBATCH * SEQ)) / NGW), r_end = (int)(((long)(gw + 1) * (NBATCH * SEQ)) / NGW);
    f32x4 g[8];
#pragma unroll
    for (int j = 0; j < 8; ++j) g[j] = *(const f32x4*)(gn + 256 * j + 4 * lane);
    for (int r0 = r_begin; r0 < r_end; r0 += 2) {
        f32x4 v[2][8];
#pragma unroll
        for (int u = 0; u < 2; ++u) { const int r = r0 + u;
            if (r < r_end) { const bf16* xr = xres_row(F, (r >> 12) * RPB + CTX + (r & 4095));
#pragma unroll
                for (int j = 0; j < 8; ++j) v[u][j] = ld4bf(xr + 256 * j + 4 * lane); } }
#pragma unroll
        for (int u = 0; u < 2; ++u) { const int r = r0 + u;
            if (r < r_end) { float* xr = F.out() + (size_t)r * DM; float ss = 0.f;
#pragma unroll
                for (int j = 0; j < 8; ++j) ss += (v[u][j][0] * v[u][j][0] + v[u][j][1] * v[u][j][1]) + (v[u][j][2] * v[u][j][2] + v[u][j][3] * v[u][j][3]);
                const float rinv = rsqrtf(wave_sum(ss) * (1.f / DM) + EPS);
#pragma unroll
                for (int j = 0; j < 8; ++j) { const int c = 256 * j + 4 * lane; __builtin_nontemporal_store(v[u][j] * rinv * g[j], (f32x4*)(xr + c)); } } }
    }
}

constexpr int CW_BAD = 12416;
#if PROBE_ATTN
__device__ __forceinline__ void attn_check(Frame& F, int l) {
    LAS float* qv = (LAS float*)F.lds;
    LAS float* sc = qv + 256;
    LAS float* red = sc + 4352;
    const bf16* dbg = (const bf16*)(F.ws() + WS_END);
    for (int s = F.bx; s < 384; s += F.G) {
        const int u = s / 6, kind = (s / 3) & 1, ri = s % 3, rloc = ri == 0 ? 0 : (ri == 1 ? 100 : 255), b = u >> 4, h = u & 15;
        const int qrow = kind == 0 ? b * RPB + CTX + 3 * 256 + rloc : b * RPB + rloc, seq = kind == 0 ? RPB : CTX;
        __syncthreads();
#if ATT_FP8
        if (F.tid < 128) { const size_t qi = (size_t)qrow * NQ + h * 192 + F.tid; qv[F.tid] = __builtin_amdgcn_cvt_f32_fp8((int)F.Q8()[qi], 0) * (1.f / (QK_C * (float)(1 << SH_QC))); }
#else
        if (F.tid < 128) qv[F.tid] = bf2f(F.Q()[(size_t)qrow * NQ + h * 192 + F.tid]);
#endif
        if (F.tid >= 128 && F.tid < 192) { const int i = F.tid - 128; float a = 0.f;
#if ATT_FP8
            for (int k = 0; k < 384; ++k) a += __builtin_amdgcn_cvt_f32_fp8((int)((const unsigned char*)(F.P() + (size_t)qrow * NP))[P_Q * 2 + k], 0) * (1.f / (float)(1 << SH_LAT)) * F.in(11)[((size_t)l * 384 + k) * NQ + h * 192 + 128 + i];
#else
            for (int k = 0; k < 384; ++k) a += bf2f(F.P()[(size_t)qrow * NP + P_Q + k]) * F.in(11)[((size_t)l * 384 + k) * NQ + h * 192 + 128 + i];
#endif
            qv[128 + i] = a; }
        __syncthreads();
        if (kind == 0 && F.tid < 32) { const int i = F.tid, pos = qrow - b * RPB - CTX; const float inv = __builtin_amdgcn_exp2f(-(float)(i & 15) * 0.830482023721841f), ang = (float)(i < 16 ? pos / 64 : pos % 64) * inv;
            const float c = __cosf(ang), sn = __sinf(ang), x1 = qv[128 + i], x2 = qv[160 + i]; qv[128 + i] = x1 * c - x2 * sn; qv[160 + i] = x2 * c + x1 * sn; }
        __syncthreads();
        float mx = -1e30f;
        for (int j = F.tid; j < seq; j += 512) { const size_t kr = (size_t)b * RPB + j; float a = 0.f;
#if ATT_FP8
            for (int d = 0; d < 128; ++d) a += qv[d] * __builtin_amdgcn_cvt_f32_fp8((int)F.K8()[kr * DM + h * 128 + d], 0) * (1.f / (float)(1 << SH_K));
#else
            for (int d = 0; d < 128; ++d) a += qv[d] * bf2f(F.KV()[kr * NKV + h * 256 + d]);
#endif
            for (int i = 0; i < 32; ++i) { float x1 = bf2f(F.P()[kr * NP + P_KPE + i]), x2 = bf2f(F.P()[kr * NP + P_KPE + 32 + i]);
                if (j >= CTX) { const int pos = j - CTX; const float inv = __builtin_amdgcn_exp2f(-(float)(i & 15) * 0.830482023721841f), ang = (float)(i < 16 ? pos / 64 : pos % 64) * inv; const float c = __cosf(ang), sn = __sinf(ang);
                    const float y1 = x1 * c - x2 * sn, y2 = x2 * c + x1 * sn; x1 = y1; x2 = y2; }
                a += qv[128 + i] * x1 + qv[160 + i] * x2; }
            a *= 0.07216878364870322f; sc[j] = a; mx = fmaxf(mx, a); }
        red[F.tid] = mx; __syncthreads();
        if (F.tid == 0) { float m = -1e30f; for (int k = 0; k < 512; ++k) m = fmaxf(m, red[k]); red[0] = m; } __syncthreads();
        mx = red[0]; __syncthreads();
        float sm = 0.f; for (int j = F.tid; j < seq; j += 512) { const float p = __builtin_amdgcn_exp2f((sc[j] - mx) * 1.4426950408889634f); sc[j] = p; sm += p; }
        red[F.tid] = sm; __syncthreads();
        if (F.tid == 0) { float t = 0.f; for (int k = 0; k < 512; ++k) t += red[k]; red[0] = t; } __syncthreads();
        sm = red[0]; __syncthreads();
        float e2 = 0.f, o2 = 0.f;
#if ATT_FP8
        if (F.tid < 128) { float o = 0.f;
            for (int j = 0; j < seq; ++j) { const int kk = j & 63, c = kk & 31, slot = (j & ~63) + 32 * ((c >> 2) & 1) + 16 * (kk >> 5) + (c & 3) + 4 * (c >> 3);
                o += sc[j] * __builtin_amdgcn_cvt_f32_fp8((int)F.VT8()[((size_t)(b * NH + h) * 128 + F.tid) * RPB + slot], 0) * (1.f / (float)(1 << SH_V)); }
#else
        if (F.tid < 128) { float o = 0.f; for (int j = 0; j < seq; ++j) o += sc[j] * bf2f(F.KV()[((size_t)b * RPB + j) * NKV + h * 256 + 128 + F.tid]);
#endif
            o /= sm; const float got = bf2f(dbg[((size_t)(u * 2 + kind) * 256 + rloc) * 128 + F.tid]); e2 = (o - got) * (o - got); o2 = o * o; }
        red[F.tid] = e2; __syncthreads();
        float esum = 0.f; if (F.tid == 0) { for (int k = 0; k < 128; ++k) esum += red[k]; } __syncthreads();
        red[F.tid] = o2; __syncthreads();
        if (F.tid == 0) { float t = 0.f; for (int k = 0; k < 128; ++k) t += red[k]; if (!(esum <= 1.6e-3f * t)) __hip_atomic_fetch_add(F.ctl() + CW_BAD, 1u, __ATOMIC_RELAXED, __HIP_MEMORY_SCOPE_AGENT); }
        __syncthreads();
    }
}
#endif
constexpr int NPHASE = 20;
__global__ void __launch_bounds__(NWAVES * 64, 2) fwd(Args args) {
    extern __shared__ __attribute__((aligned(16))) unsigned char lds[];
    Frame F; F.lds = (LAS unsigned char*)lds; F.wave = __builtin_amdgcn_readfirstlane((int)threadIdx.x >> 6); F.fresh();
    volatile LAS unsigned* MISC = (volatile LAS unsigned*)(F.lds + L_MISC);
    if (F.tid < 128) MISC[F.tid] = 0u;
    __syncthreads();
    const int lo = args.ph_lo, hi = args.ph_hi;
    const bool multi = (hi - lo) > 1;
    if (multi) (void)xcd_barrier_post(F.ctl() + CW_BAR, MISC + 8, F.tid == 0);
#ifndef ONLY_PH
#define ONLY_PH -1
#endif
#define SEL(kind) (ONLY_PH < 0 || ONLY_PH == (kind))
#ifndef PROBE_DUP
#define PROBE_DUP -1
#endif
#define DUP(kind) (PROBE_DUP == (kind))
#define IN(k) (lo <= (k) && (k) < hi)
#define SEAM(k) do { if (IN(k) && IN((k) + 1)) { F.fresh(); XcdBarrier b_; b_.bar = F.ctl() + CW_BAR; b_.x = xb_xcc_id(); b_.st = MISC + 8; xcd_barrier(b_, F.tid == 0); if (DUP(99)) xcd_barrier(b_, F.tid == 0); } } while (0)

    if (SEL(0) && IN(0)) { F.fresh(); p0_prologue(F); __syncthreads(); if (DUP(0)) { p0_prologue(F); __syncthreads(); } SEAM(0); }

    for (int l = 0; l < DEPTH; ++l) {
        const int pb = 1 + 9 * l; const bool lastl = (l == DEPTH - 1);
#define WL (F.ws() + WS_W + (size_t)l * LW_BYTES)
#define MODL (F.mod() + (size_t)l * 5 * NMOD)
        if (SEL(1) && IN(pb + 0)) { F.fresh(); t1_phase(F, l); if (DUP(1)) t1_phase(F, l); SEAM(pb + 0); }
        if (SEL(2) && IN(pb + 1)) { F.fresh();
            pg8::EpiP E{F.P()};
            { pg8::A8Sched S{(const unsigned char*)F.Z(), (const unsigned char*)(WL + LW_IN8), F.G, F.bx};
              pg8::gemm_phase<pg8::EpiP, pg8::A8Sched, true>(F.lds, F.wave, S, E); if (DUP(2) || DUP(22)) pg8::gemm_phase<pg8::EpiP, pg8::A8Sched, true>(F.lds, F.wave, S, E);
              if (DUP(23)) { pg8::EpiNull E0{F.mod()}; pg8::gemm_phase<pg8::EpiNull, pg8::A8Sched, true>(F.lds, F.wave, S, E0); } }
            if (l == 0) conv_queue(F, F.ctl() + CW_Q1, ITO_GU, IT_LAYER);
            if (DUP(97) && l == 0) conv_queue(F, F.ctl() + CW_Q1 + 128, ITO_GU, IT_LAYER);
            SEAM(pb + 1);
        }
        if (SEL(3) && IN(pb + 2)) { F.fresh(); if (DUP(3)) t2_phase(F, l, F.G != 12345); t2_phase(F, l, false); SEAM(pb + 2); }
        if (SEL(4) && IN(pb + 3)) { F.fresh();
#if ATT_FP8
            { pg8::KQ8Sched S{F.ws(), WS_W + (size_t)l * LW_BYTES, F.G, F.bx, lastl ? 64 : T / 256, lastl};
              pg8::EpiKQ8 E{{F.K8(), F.VT8()}, {F.Q8(), F.cosT(), F.sinT()}};
              pg8::gemm_phase<pg8::EpiKQ8, pg8::KQ8Sched, true>(F.lds, F.wave, S, E); if (DUP(4) || DUP(44)) pg8::gemm_phase<pg8::EpiKQ8, pg8::KQ8Sched, true>(F.lds, F.wave, S, E); }
            { pg8::Pool8Sched S{(const unsigned char*)F.Z(), (const unsigned char*)(WL + LW_POOL), F.G, (F.bx + F.G / 2) % F.G, lastl ? 64 : T / 256, lastl};
              pg8::EpiPool E{F.HM(), F.P(), F.in(14) + (size_t)l * DM};
              pg8::gemm_phase<pg8::EpiPool, pg8::Pool8Sched, true>(F.lds, F.wave, S, E); if (DUP(4) || DUP(45)) pg8::gemm_phase<pg8::EpiPool, pg8::Pool8Sched, true>(F.lds, F.wave, S, E); }
#else
            pg8::TriSched S{F.ws(), WS_W + (size_t)l * LW_BYTES, F.G, F.bx, lastl ? 64 : T / 256, lastl};
            pg8::EpiTri E{{F.KV(), NKV}, {F.Q(), F.cosT(), F.sinT()}, {F.HM(), F.P(), F.in(14) + (size_t)l * DM}};
            pg8::gemm_phase<pg8::EpiTri, pg8::TriSched, true>(F.lds, F.wave, S, E);
            if (DUP(4)) pg8::gemm_phase<pg8::EpiTri, pg8::TriSched, true>(F.lds, F.wave, S, E);
#endif
            SEAM(pb + 3);
        }
        if (SEL(5) && IN(pb + 4)) { F.fresh();
            const int nunits = NBATCH * NH * 16 + (l == 0 ? NBATCH * NH : 0);
            for (int rep = DUP(5) ? 0 : 1; rep < 2; ++rep)
            for (int i = 0;; ++i) { const int L = i * F.G + F.vcu; if (L >= nunits) break;
                int b, h, q0, seq;
                if (L < NBATCH * NH * 16) { const int bh = L >> 4, qb = L & 15; b = bh >> 4; h = bh & 15; q0 = b * RPB + CTX + qb * 256; seq = RPB; }
                else { const int bh = L - NBATCH * NH * 16; b = bh >> 4; h = bh & 15; q0 = b * RPB; seq = CTX; }
                const size_t k0 = (size_t)b * RPB;
#if PROBE_ATTN
                __syncthreads();
                if (F.tid == 0) *(bf16* volatile*)((char*)lds + L_MISC + 64) = (L >= NBATCH * NH * 16) ? (bf16*)(F.ws() + WS_END) + ((size_t)((b * 16 + h) * 2 + 1) * 256) * 128
                                                                               : (((L & 15) == 3) ? (bf16*)(F.ws() + WS_END) + ((size_t)((b * 16 + h) * 2 + 0) * 256) * 128 : (bf16*)nullptr);
#endif
#if ATT_FP8
                att8::attn_unit(F.Q8() + (size_t)q0 * NQ + h * 192, F.K8() + k0 * DM + h * 128, F.KPE8() + k0 * 64, F.VT8() + (size_t)(b * NH + h) * 128 * RPB,
                                F.HM() + (size_t)q0 * DM + h * 128, F.P() + (size_t)q0 * NP + P_GM + h * 128, F.M8() + (size_t)q0 * DM + h * 128, seq, (char*)lds, rep == 0, F.wave); }
#else
                att::attn_unit(F.Q() + (size_t)q0 * NQ + h * 192, F.KV() + k0 * NKV + h * 256, F.KV() + k0 * NKV + h * 256 + 128, F.KPE() + k0 * 64,
                               F.HM() + (size_t)q0 * DM + h * 128, F.P() + (size_t)q0 * NP + P_GM + h * 128, seq, (char*)lds, rep == 0, F.wave); }
#endif
            __syncthreads();
            SEAM(pb + 4);
        }
        if (SEL(6) && IN(pb + 5)) { F.fresh();
#if PROBE_ATTN
            if (l == 0) { attn_check(F, l); __syncthreads(); }
#endif
            pg8::EpiRes E{&F, false, MODL + 2 * DM};
#if ATT_FP8
            pg8::D8Sched S{F.M8(), (const unsigned char*)(WL + LW_OUT), F.G, F.bx, lastl ? 64 : T / 256, lastl};
            pg8::gemm_phase<pg8::EpiRes, pg8::D8Sched, true>(F.lds, F.wave, S, E);
            if (DUP(6) && l == 0) pg8::gemm_phase<pg8::EpiRes, pg8::D8Sched, true>(F.lds, F.wave, S, E);
#else
            pg8::DenseSched S{F.HM(), (const bf16*)(WL + LW_OUT), DM, DM, lastl ? 64 : T / 256, DM / 256, F.G, F.bx, 0, 0, lastl, DM, 0};
            pg8::gemm_phase<pg8::EpiRes, pg8::DenseSched, true>(F.lds, F.wave, S, E);
            if (DUP(6) && l == 0) pg8::gemm_phase<pg8::EpiRes, pg8::DenseSched, true>(F.lds, F.wave, S, E);
#endif
            if (l == 0) conv_queue(F, F.ctl() + CW_Q2, IT_LAYER, 2 * IT_LAYER);
            if (DUP(97) && l == 0) conv_queue(F, F.ctl() + CW_Q2 + 128, IT_LAYER, 2 * IT_LAYER);
            SEAM(pb + 5);
        }
        if (SEL(7) && IN(pb + 6)) { F.fresh(); if (DUP(7)) t3_phase(F, l, F.G != 12345); t3_phase(F, l, false); SEAM(pb + 6); }
        if (SEL(8) && IN(pb + 7)) { F.fresh();
            moe_setup(F, l, 12);
            pg8::MoeUpSched S{(const unsigned char*)F.HM(), (const unsigned char*)(WL + LW_GU), F.G, F.bx, (const volatile LAS int*)(F.ldsx + L_TAB), (const volatile LAS int*)(F.ldsx + L_CIDX)};
            pg8::EpiUp E{(unsigned char*)F.ACT(), (const volatile LAS float*)(F.ldsx + L_CWA), (const volatile LAS float*)(F.ldsx + L_CWB)};
            pg8::gemm_phase<pg8::EpiUp, pg8::MoeUpSched, true>(F.lds, F.wave, S, E);
            if (DUP(8)) pg8::gemm_phase<pg8::EpiUp, pg8::MoeUpSched, true>(F.lds, F.wave, S, E);
            SEAM(pb + 7);
        }
        if (SEL(9) && IN(pb + 8)) { F.fresh();
            moe_setup(F, l, 8, SEL(8) && IN(pb + 7));
            pg8::MoeDownSched S{(const unsigned char*)F.ACT(), (const unsigned char*)(WL + LW_D), F.G, F.bx, (const volatile LAS int*)(F.ldsx + L_TAB)};
            if (DUP(9)) { pg8::EpiDown E0{&F, MODL + 5 * DM, (const volatile LAS int*)(F.ldsx + L_CIDX), F.G != 12345};
                pg8::gemm_phase<pg8::EpiDown, pg8::MoeDownSched, true>(F.lds, F.wave, S, E0); }
            pg8::EpiDown E{&F, MODL + 5 * DM, (const volatile LAS int*)(F.ldsx + L_CIDX), false};
            pg8::gemm_phase<pg8::EpiDown, pg8::MoeDownSched, true>(F.lds, F.wave, S, E);
            SEAM(pb + 8);
        }
    }
    if (SEL(10) && IN(19)) { F.fresh(); final_phase(F);
#if PROBE_ATTN
        if (__hip_atomic_load(F.ctl() + CW_BAD, __ATOMIC_RELAXED, __HIP_MEMORY_SCOPE_AGENT) != 0u && F.tid == 0) F.out()[F.bx] = __builtin_nanf("");
#endif
    }
#undef IN
#undef SEAM
}

extern "C" void kernel_launch(void* const* d_in, const int* in_sizes, int n_in, void* d_out, int out_size, void* d_ws, size_t ws_size, hipStream_t stream) {
    static int grid = 0;
    if (grid == 0) {
        if (n_in != 25 || out_size != NBATCH * SEQ * DM || ws_size < WS_END) { fprintf(stderr, "kernel_launch: unexpected shapes (n_in %d out %d ws %zu)\n", n_in, out_size, ws_size); grid = -1; return; }
        int dev = 0, cus = 0;
        if (hipGetDevice(&dev) != hipSuccess || hipDeviceGetAttribute(&cus, hipDeviceAttributeMultiprocessorCount, dev) != hipSuccess) { grid = -1; return; }
        if (hipFuncSetAttribute((const void*)fwd, hipFuncAttributeMaxDynamicSharedMemorySize, LDS_BYTES) != hipSuccess) { fprintf(stderr, "kernel_launch: hipFuncSetAttribute failed\n"); grid = -1; return; }
        int per_cu = 0;
        if (hipOccupancyMaxActiveBlocksPerMultiprocessor(&per_cu, (const void*)fwd, NWAVES * 64, LDS_BYTES) != hipSuccess || per_cu < 1) { fprintf(stderr, "kernel_launch: occupancy query says %d\n", per_cu); }
        (void)hipGetLastError();
        grid = cus;
    }
    if (grid < 0) return;
    (void)hipMemsetAsync((char*)d_ws + WS_CTL, 0, CTL_ZERO_BYTES, stream);
    Args a{};
    for (int i = 0; i < 25; ++i) a.in[i] = (const float*)d_in[i];
    a.out = (float*)d_out; a.ws = (unsigned char*)d_ws;
#if MK_PER_PHASE
    for (int k = 0; k < NPHASE; ++k) { a.ph_lo = k; a.ph_hi = k + 1; hipLaunchKernelGGL(fwd, dim3(grid), dim3(NWAVES * 64), LDS_BYTES, stream, a); }
#else
    a.ph_lo = 0; a.ph_hi = NPHASE; hipLaunchKernelGGL(fwd, dim3(grid), dim3(NWAVES * 64), LDS_BYTES, stream, a);
#endif
}
```
